# Optimizing an MI355X kernel written in HIP

```python
import math
import jax, jax.numpy as jnp
from jax import lax
import numpy as np

D_MODEL = 1024
BATCH = 4
SEQ = 4096
DEPTH = 2
DEC_BATCH = 32
DEC_SEQ = 4
PAST_LEN = 8192
PAGE_SIZE = 128

N_A_LAYERS = DEPTH // 2
N_B_LAYERS = DEPTH - N_A_LAYERS

SSM_INNER = 2 * D_MODEL
SSM_HEAD_DIM = 64
SSM_HEADS = SSM_INNER // SSM_HEAD_DIM
SSM_GROUPS = 4
SSM_HEADS_PER_GROUP = SSM_HEADS // SSM_GROUPS
SSM_STATE = 128
CONV_WIDTH = 4
CONV_DIM = SSM_INNER + 2 * SSM_GROUPS * SSM_STATE
SSM_CHUNK = 128
SSM_IN_DIM = SSM_INNER + CONV_DIM + SSM_HEADS

ATT_HEAD_DIM = 128
KV_HEADS = D_MODEL // ATT_HEAD_DIM
WINDOWS = (128, 512, 2048)
DILATIONS = (1, 4, 16)
N_DIL_GROUPS = len(WINDOWS)
Q_HEADS = N_DIL_GROUPS * KV_HEADS
Q_WIDTH = Q_HEADS * ATT_HEAD_DIM
ATT_WIDTH = KV_HEADS * ATT_HEAD_DIM
B_IN_DIM = Q_WIDTH + ATT_WIDTH
WINDOW_MAX = max(WINDOWS)
N_BUCKETS = 32
MAX_DISTANCE = WINDOW_MAX

NORM_EPS = 1e-5
NEG_INF = -1e30

kernel_name = "yoco_ssd_dilated_window_step"


def rmsnorm(x, g):
    xf = x.astype(jnp.float32)
    y = xf * lax.rsqrt(jnp.mean(xf * xf, axis=-1, keepdims=True) + NORM_EPS)
    return (y * g.astype(jnp.float32)).astype(x.dtype)


def t5_bucket(dist):
    max_exact = N_BUCKETS // 2
    n = jnp.maximum(dist, 0)
    nf = jnp.maximum(n, 1).astype(jnp.float32)
    large = max_exact + (jnp.log(nf / max_exact) / math.log(MAX_DISTANCE / max_exact)
                         * (N_BUCKETS - max_exact)).astype(jnp.int32)
    large = jnp.minimum(large, N_BUCKETS - 1)
    return jnp.where(n < max_exact, n, large)


def group_bias(rel_bias, g):
    nw = WINDOWS[g] // DILATIONS[g]
    dist = jnp.arange(nw + 1, dtype=jnp.int32) * DILATIONS[g]
    cols = rel_bias[:, g * KV_HEADS:(g + 1) * KV_HEADS].astype(jnp.float32)
    return cols[t5_bucket(dist)]


def ssd_scan(xdt, adt, bm, cm, init):
    b, l, nh, p = xdt.shape
    T = min(SSM_CHUNK, l)
    nc = -(-l // T)
    lp = nc * T

    def pad(t):
        return jnp.pad(t, ((0, 0), (0, lp - l)) + ((0, 0),) * (t.ndim - 2))

    G, J = SSM_GROUPS, SSM_HEADS_PER_GROUP
    X = pad(xdt).reshape(b, nc, T, G, J, p)
    A = pad(adt).reshape(b, nc, T, G, J).transpose(0, 3, 4, 1, 2)
    Bc = pad(bm).reshape(b, nc, T, G, SSM_STATE)
    Cc = pad(cm).reshape(b, nc, T, G, SSM_STATE)
    a_cs = jnp.cumsum(A, axis=-1)
    tri = jnp.tril(jnp.ones((T, T), dtype=bool))
    seg = jnp.exp(jnp.where(tri, a_cs[..., :, None] - a_cs[..., None, :], -jnp.inf))
    cb = jnp.einsum("bctgn,bcsgn->bcgts", Cc, Bc)
    m = jnp.einsum("bcgts,bgjcts->bcgjts", cb, seg)
    y_diag = jnp.einsum("bcgjts,bcsgjp->bctgjp", m, X)
    decay_in = jnp.exp(a_cs[..., -1:] - a_cs)
    chunk_states = jnp.einsum("bctgn,bgjct,bctgjp->cbgjpn", Bc, decay_in, X)
    chunk_decay = jnp.exp(a_cs[..., -1]).transpose(3, 0, 1, 2)
    s0 = init.reshape(b, G, J, p, SSM_STATE)

    def step(s, inp):
        dec, cs = inp
        return dec[..., None, None] * s + cs, s

    s_final, s_in = lax.scan(step, s0, (chunk_decay, chunk_states))
    y_off = jnp.einsum("bctgn,cbgjpn,bgjct->bctgjp", Cc, s_in, jnp.exp(a_cs))
    y = (y_diag + y_off).reshape(b, lp, nh, p)[:, :l]
    return y, s_final.reshape(b, nh, p, SSM_STATE)


def ssd_mixer(h, conv_prev, ssm_init, g_norm, w_in, conv_w, conv_b, dt_bias, a_log, d_skip,
              g_gate, w_out):
    b, l, _ = h.shape
    u = rmsnorm(h, g_norm) @ w_in
    z = u[..., :SSM_INNER]
    xbc = u[..., SSM_INNER:SSM_INNER + CONV_DIM]
    dt_raw = u[..., SSM_INNER + CONV_DIM:]
    xc = jnp.concatenate([conv_prev.astype(xbc.dtype), xbc], axis=1)
    conv = conv_b
    for k in range(CONV_WIDTH):
        conv = conv + xc[:, k:k + l] * conv_w[k]
    new_conv = xc[:, l:]
    act = jax.nn.silu(conv.astype(jnp.float32))
    xs = act[..., :SSM_INNER].reshape(b, l, SSM_HEADS, SSM_HEAD_DIM)
    gn = SSM_GROUPS * SSM_STATE
    bm = act[..., SSM_INNER:SSM_INNER + gn].reshape(b, l, SSM_GROUPS, SSM_STATE)
    cm = act[..., SSM_INNER + gn:].reshape(b, l, SSM_GROUPS, SSM_STATE)
    dt = jax.nn.softplus(dt_raw.astype(jnp.float32) + dt_bias.astype(jnp.float32))
    a = -jnp.exp(a_log.astype(jnp.float32))
    y, s_final = ssd_scan(xs * dt[..., None], dt * a, bm, cm, ssm_init.astype(jnp.float32))
    y = y + xs * d_skip.astype(jnp.float32)[:, None]
    y = rmsnorm(y.reshape(b, l, SSM_INNER) * jax.nn.silu(z.astype(jnp.float32)), g_gate)
    return y.astype(h.dtype) @ w_out, new_conv, s_final


def dilated_attn_prompt(q, k, v, bvec, dil, nw):
    b, s, h, dh = q.shape
    m = s // dil
    lb = nw
    nb = -(-m // lb)
    mp = nb * lb

    def to_sub(t):
        t = t.reshape(b, m, dil, h, dh).transpose(0, 2, 1, 3, 4)
        return jnp.pad(t, ((0, 0), (0, 0), (0, mp - m), (0, 0), (0, 0)))

    def key_blocks(t):
        t = jnp.pad(to_sub(t), ((0, 0), (0, 0), (lb, 0), (0, 0), (0, 0)))
        t = t.reshape(b, dil, nb + 1, lb, h, dh)
        return jnp.concatenate([t[:, :, :-1], t[:, :, 1:]], axis=3)

    qs = to_sub(q).reshape(b, dil, nb, lb, h, dh)
    kb = key_blocks(k)
    vb = key_blocks(v)
    scores = jnp.einsum("brnqhd,brnkhd->brnhqk", qs, kb) * (dh ** -0.5)
    rel = lb + jnp.arange(lb)[:, None] - jnp.arange(2 * lb)[None, :]
    band = (rel >= 0) & (rel <= nw)
    bias = bvec[jnp.clip(rel, 0, nw)].transpose(2, 0, 1)
    key_ok = (jnp.arange(nb)[:, None] - 1) * lb + jnp.arange(2 * lb)[None, :] >= 0
    valid = band[None, None] & key_ok[:, None, None, :]
    scores = jnp.where(valid, scores + bias, NEG_INF)
    lse = jax.nn.logsumexp(scores, axis=-1)
    p = jnp.exp(scores - lse[..., None])
    o = jnp.einsum("brnhqk,brnkhd->brnqhd", p, vb)
    o = o.reshape(b, dil, mp, h, dh)[:, :, :m].transpose(0, 2, 1, 3, 4).reshape(b, s, h, dh)
    lse = lse.transpose(0, 1, 2, 4, 3).reshape(b, dil, mp, h)[:, :, :m]
    lse = lse.transpose(0, 2, 1, 3).reshape(b, s, h)
    return o, lse


def dilated_attn_sample(q, kc, vc, bvec, dil, nw, n_old):
    t = q.shape[1]
    idx = n_old + jnp.arange(t)[:, None] - dil * jnp.arange(nw + 1)[None, :]
    valid = idx >= 0
    idx = jnp.maximum(idx, 0)
    kg = kc[:, idx]
    vg = vc[:, idx]
    scores = jnp.einsum("bthd,btjhd->bthj", q, kg) * (q.shape[-1] ** -0.5) + bvec.T[None, None]
    scores = jnp.where(valid[None, :, None, :], scores, NEG_INF)
    lse = jax.nn.logsumexp(scores, axis=-1)
    p = jnp.exp(scores - lse[..., None])
    o = jnp.einsum("bthj,btjhd->bthd", p, vg)
    return o, lse


def dilated_mixer(h, attend, biases, g_norm, w_in, w_out):
    b, l, _ = h.shape
    u = rmsnorm(h, g_norm) @ w_in
    q = u[..., :Q_WIDTH].reshape(b, l, N_DIL_GROUPS, KV_HEADS, ATT_HEAD_DIM).astype(jnp.float32)
    gate = u[..., Q_WIDTH:].astype(jnp.float32)
    outs, lses = [], []
    for g in range(N_DIL_GROUPS):
        o, lse = attend(q[:, :, g], biases[g], DILATIONS[g], WINDOWS[g] // DILATIONS[g])
        outs.append(o)
        lses.append(lse)
    w = jax.nn.softmax(jnp.stack(lses, axis=0), axis=0)
    o = jnp.sum(w[..., None] * jnp.stack(outs, axis=0), axis=0)
    y = o.reshape(b, l, ATT_WIDTH) * jax.nn.silu(gate)
    return y.astype(h.dtype) @ w_out


def shared_kv(h, g, w_kv):
    b, l, _ = h.shape
    return (rmsnorm(h, g) @ w_kv).reshape(b, l, 2, KV_HEADS, ATT_HEAD_DIM)


def setup_inputs(seed: int = 0) -> dict:
    key = jax.random.key(seed)
    ks = jax.random.split(key, 24)
    nrm = jax.random.normal
    f32 = jnp.float32
    n_old = min(WINDOW_MAX, PAST_LEN)
    dt0 = jnp.exp(jax.random.uniform(ks[0], (N_A_LAYERS, SSM_HEADS), f32)
                  * (math.log(0.1) - math.log(0.001)) + math.log(0.001))
    return {
        "x_prompt": nrm(ks[1], (BATCH, SEQ, D_MODEL), f32),
        "x_sample": nrm(ks[2], (DEC_BATCH, DEC_SEQ, D_MODEL), f32),
        "state_ssm": 0.5 * nrm(ks[3], (N_A_LAYERS, DEC_BATCH, SSM_HEADS, SSM_HEAD_DIM, SSM_STATE), f32),
        "state_conv": nrm(ks[4], (N_A_LAYERS, DEC_BATCH, CONV_WIDTH - 1, CONV_DIM), f32),
        "cache_kv": nrm(ks[5], (DEC_BATCH, n_old, 2, KV_HEADS, ATT_HEAD_DIM), f32),
        "a_norm": 1.0 + 0.02 * nrm(ks[6], (N_A_LAYERS, D_MODEL), f32),
        "a_w_in": nrm(ks[7], (N_A_LAYERS, D_MODEL, SSM_IN_DIM), f32) * D_MODEL ** -0.5,
        "a_conv_w": nrm(ks[8], (N_A_LAYERS, CONV_WIDTH, CONV_DIM), f32) * CONV_WIDTH ** -0.5,
        "a_conv_b": 0.02 * nrm(ks[9], (N_A_LAYERS, CONV_DIM), f32),
        "a_dt_bias": dt0 + jnp.log(-jnp.expm1(-dt0)),
        "a_A_log": jnp.log(jax.random.uniform(ks[10], (N_A_LAYERS, SSM_HEADS), f32, 1.0, 16.0)),
        "a_D": 1.0 + 0.02 * nrm(ks[11], (N_A_LAYERS, SSM_HEADS), f32),
        "a_gate_norm": 1.0 + 0.02 * nrm(ks[12], (N_A_LAYERS, SSM_INNER), f32),
        "a_w_out": nrm(ks[13], (N_A_LAYERS, SSM_INNER, D_MODEL), f32) * SSM_INNER ** -0.5,
        "rel_bias": 0.5 * nrm(ks[14], (N_BUCKETS, Q_HEADS), f32),
        "kv_norm": 1.0 + 0.02 * nrm(ks[15], (D_MODEL,), f32),
        "w_kv": nrm(ks[16], (D_MODEL, 2 * ATT_WIDTH), f32) * D_MODEL ** -0.5,
        "b_norm": 1.0 + 0.02 * nrm(ks[17], (N_B_LAYERS, D_MODEL), f32),
        "b_w_in": nrm(ks[18], (N_B_LAYERS, D_MODEL, B_IN_DIM), f32) * D_MODEL ** -0.5,
        "b_w_out": nrm(ks[19], (N_B_LAYERS, ATT_WIDTH, D_MODEL), f32) * ATT_WIDTH ** -0.5,
        "final_norm": 1.0 + 0.02 * nrm(ks[20], (D_MODEL,), f32),
    }


def reference(x_prompt, x_sample, state_ssm, state_conv, cache_kv, a_norm, a_w_in, a_conv_w,
              a_conv_b, a_dt_bias, a_A_log, a_D, a_gate_norm, a_w_out, rel_bias, kv_norm, w_kv,
              b_norm, b_w_in, b_w_out, final_norm):
    hp, hs = x_prompt, x_sample
    bp, sp = x_prompt.shape[0], x_prompt.shape[1]
    n_old = cache_kv.shape[1]
    biases = [group_bias(rel_bias, g) for g in range(N_DIL_GROUPS)]
    ssm_p, ssm_s, conv_p, conv_s = [], [], [], []
    attend_p = attend_s = None
    kv_p = kv_s = None
    for layer in range(DEPTH):
        if layer < N_A_LAYERS:
            i = layer
            params = (a_norm[i], a_w_in[i], a_conv_w[i], a_conv_b[i], a_dt_bias[i], a_A_log[i],
                      a_D[i], a_gate_norm[i], a_w_out[i])
            conv0 = jnp.zeros((bp, CONV_WIDTH - 1, CONV_DIM), hp.dtype)
            ssm0 = jnp.zeros((bp, SSM_HEADS, SSM_HEAD_DIM, SSM_STATE), jnp.float32)
            o, c, s = ssd_mixer(hp, conv0, ssm0, *params)
            hp = hp + o
            conv_p.append(c)
            ssm_p.append(s)
            o, c, s = ssd_mixer(hs, state_conv[i], state_ssm[i], *params)
            hs = hs + o
            conv_s.append(c)
            ssm_s.append(s)
            if layer == N_A_LAYERS - 1:
                kv_p = shared_kv(hp, kv_norm, w_kv)
                kv_s = shared_kv(hs, kv_norm, w_kv)
                k_p = kv_p[:, :, 0].astype(jnp.float32)
                v_p = kv_p[:, :, 1].astype(jnp.float32)
                kc = jnp.concatenate([cache_kv[:, :, 0].astype(jnp.float32),
                                      kv_s[:, :, 0].astype(jnp.float32)], axis=1)
                vc = jnp.concatenate([cache_kv[:, :, 1].astype(jnp.float32),
                                      kv_s[:, :, 1].astype(jnp.float32)], axis=1)
                attend_p = (lambda q, bv, d, nw, k_p=k_p, v_p=v_p:
                            dilated_attn_prompt(q, k_p, v_p, bv, d, nw))
                attend_s = (lambda q, bv, d, nw, kc=kc, vc=vc:
                            dilated_attn_sample(q, kc, vc, bv, d, nw, n_old))
        else:
            j = layer - N_A_LAYERS
            hp = hp + dilated_mixer(hp, attend_p, biases, b_norm[j], b_w_in[j], b_w_out[j])
            hs = hs + dilated_mixer(hs, attend_s, biases, b_norm[j], b_w_in[j], b_w_out[j])
    y_prompt = rmsnorm(hp, final_norm)
    y_sample = rmsnorm(hs, final_norm)
    ssm_prompt = jnp.stack(ssm_p, axis=0).astype(state_ssm.dtype)
    ssm_sample = jnp.stack(ssm_s, axis=0).astype(state_ssm.dtype)
    conv_prompt = jnp.stack(conv_p, axis=0).astype(state_conv.dtype)
    conv_sample = jnp.stack(conv_s, axis=0).astype(state_conv.dtype)
    kv_prompt = kv_p[:, sp - min(WINDOW_MAX, sp):].astype(cache_kv.dtype)
    kv_sample = kv_s.astype(cache_kv.dtype)
    return (y_prompt, y_sample, ssm_prompt, ssm_sample, conv_prompt, conv_sample, kv_prompt, kv_sample)
```

```cpp
#include <hip/hip_runtime.h>
#include <hip/hip_cooperative_groups.h>
#include <cstdio>
#include <cstdint>
namespace cg = cooperative_groups;
namespace pg8 {
#define PG8_LAS __attribute__((address_space(3)))
typedef unsigned short bf16_t;
typedef short bf16x8 __attribute__((ext_vector_type(8)));
typedef float f32x4 __attribute__((ext_vector_type(4)));
typedef unsigned u32x4 __attribute__((ext_vector_type(4)));
constexpr int BM = 256, BK = 64, HALF = 128, HTB = HALF * BK * 2  , STAGE_BYTES = 8 * HTB, NXCD = 8, WGM = 8;

__host__ __device__ __forceinline__ int lds_byte(int r, int c) { const int st = (r >> 4) * 2 + (c >> 5), rr = r & 15, cc = c & 31, ob = rr * 64 + cc * 2; return st * 1024 + (ob ^ (((ob >> 9) & 1) << 5)); }
__host__ __device__ __forceinline__ void stage_rc(int b, int& R, int& C) { const int st = b / 1024, sb = b % 1024, swz = sb ^ (((sb >> 9) & 1) << 5); R = (st >> 1) * 16 + swz / 64; C = (st & 1) * 32 + (swz % 64) / 2; }
__host__ __device__ __forceinline__ int perm32(int rho) { const int n = rho >> 4, i = rho & 15; return 8 * (i >> 2) + 4 * n + (i & 3); }

struct Unit { int pm, pn; };
struct Gemm { const bf16_t* A; const bf16_t* Bt; int M, N, K; };

struct StaticOrder {
    int nM, nN, nwg, G, c;
    __host__ __device__ void init(int M, int N, int G_, int c_) { nM = M / BM; nN = N / BM; nwg = nM * nN; G = G_; c = c_; }
    __host__ __device__ bool next(int i, Unit& u) const {
        const long L = (long)i * G + c; if (L >= nwg) return false;
        int wgid = (int)L; { const int q = nwg / NXCD, r = nwg % NXCD, xcd = wgid % NXCD, off = wgid / NXCD; wgid = (xcd < r ? xcd * (q + 1) : r * (q + 1) + (xcd - r) * q) + off; }
        const int nig = WGM * nN, gid = wgid / nig, fm = gid * WGM, gsz = (nM - fm) < WGM ? (nM - fm) : WGM;
        u.pm = fm + ((wgid % nig) % gsz); u.pn = (wgid % nig) / gsz; return true;
    }
    __device__ __forceinline__ void a_ready(const Unit&) const {}
    __device__ __forceinline__ void done(const Unit&) const {}
};
__device__ __forceinline__ unsigned cvt_pk_bf16(float lo, float hi) { unsigned r; asm volatile("v_cvt_pk_bf16_f32 %0, %1, %2" : "=v"(r) : "v"(lo), "v"(hi)); return r; }
typedef float f32x2 __attribute__((ext_vector_type(2)));
template <class Epi, class Sched, bool ALIGN_EPI = false, bool SP2 = false>
__device__ __forceinline__ void gemm_phase(PG8_LAS unsigned char* lds, const Gemm g, const Sched& S, const Epi& E) {
    const int tid = threadIdx.x, wid = __builtin_amdgcn_readfirstlane(tid >> 6), lane = tid & 63, wr = wid >> 2, wc = wid & 3, fr = lane & 15, fq = lane >> 4;
    const int K = g.K, nt = K / BK;
    unsigned voffA[2], voffB[2];
#pragma unroll
    for (int i = 0; i < 2; ++i) { int R, C; stage_rc(tid * 16 + i * 8192, R, C); const int Rb = Epi::PERM ? ((R & ~31) + perm32(R & 31)) : R;
        voffA[i] = (unsigned)(R * K + C) * 2u; voffB[i] = (unsigned)(Rb * K + C) * 2u; }
    const size_t kstep = (size_t)(BK * 2);
    const size_t hstep = (size_t)HALF * K * 2;
    const size_t tstep = 2 * hstep;
    const unsigned ldsw = (unsigned)wid * 1024u;
    const int aoff = lds_byte(wr * 64 + fr, fq * 8), boff = lds_byte(wc * 32 + fr, fq * 8);
#define PG8_SA(b, h) (((b) * 2 + (h)) * HTB)
#define PG8_SB(b, h) ((4 + (b) * 2 + (h)) * HTB)
#define PG8_STAGE(bufoff, gbase, voff) do { _Pragma("unroll") for (int _i = 0; _i < 2; ++_i) \
        __builtin_amdgcn_global_load_lds((const unsigned*)((const char*)(gbase) + (voff)[_i]), (PG8_LAS unsigned*)(lds + (bufoff) + ldsw + _i * 8192), 16, 0, 0); } while (0)
#define PG8_LDA(dst, b, h) do { _Pragma("unroll") for (int m = 0; m < 4; ++m) _Pragma("unroll") for (int k = 0; k < 2; ++k) dst[m][k] = *(const PG8_LAS bf16x8*)(lds + PG8_SA(b, h) + aoff + m * 2048 + k * 1024); } while (0)
#define PG8_LDB(dst, b, h) do { _Pragma("unroll") for (int n = 0; n < 2; ++n) _Pragma("unroll") for (int k = 0; k < 2; ++k) dst[n][k] = *(const PG8_LAS bf16x8*)(lds + PG8_SB(b, h) + boff + n * 2048 + k * 1024); } while (0)
#define PG8_MMA(ai, bj, At, Bt) do { __builtin_amdgcn_s_setprio(1); _Pragma("unroll") for (int m = 0; m < 4; ++m) _Pragma("unroll") for (int n = 0; n < 2; ++n) _Pragma("unroll") for (int k = 0; k < 2; ++k) \
        acc[ai][bj][m][n] = __builtin_amdgcn_mfma_f32_16x16x32_bf16(Bt[n][k], At[m][k], acc[ai][bj][m][n], 0, 0, 0); __builtin_amdgcn_s_setprio(0); } while (0)
#define PG8_WAIT_V(n) asm volatile("s_waitcnt vmcnt(" #n ")" ::: "memory")
#define PG8_WAIT_L(n) asm volatile("s_waitcnt lgkmcnt(" #n ")" ::: "memory")
#define PG8_BAR __builtin_amdgcn_s_barrier()
#define PG8_SCHED __builtin_amdgcn_sched_barrier(0)
    Unit cur, nxt; int ui = 0;
    if (!S.next(0, cur)) return;
    f32x4 acc[2][2][4][2];
#pragma unroll
    for (int a = 0; a < 2; ++a)
#pragma unroll
        for (int b = 0; b < 2; ++b)
#pragma unroll
            for (int m = 0; m < 4; ++m)
#pragma unroll
                for (int n = 0; n < 2; ++n) acc[a][b][m][n] = (f32x4){0.f, 0.f, 0.f, 0.f};
    bf16x8 At[4][2], B0[2][2], B1[2][2];
    const char* cA = (const char*)g.A + (size_t)cur.pm * tstep; const char* cB = (const char*)g.Bt + (size_t)cur.pn * tstep;
    S.a_ready(cur);
    if constexpr (SP2) {
        PG8_STAGE(PG8_SB(0, 0), cB, voffB); PG8_STAGE(PG8_SB(0, 1), cB + hstep, voffB); PG8_STAGE(PG8_SA(0, 0), cA, voffA); PG8_STAGE(PG8_SA(0, 1), cA + hstep, voffA);
        if (wr == 1) PG8_BAR;
        PG8_WAIT_V(2); PG8_BAR;
        PG8_STAGE(PG8_SB(1, 0), cB + kstep, voffB); PG8_STAGE(PG8_SA(1, 0), cA + kstep, voffA); PG8_STAGE(PG8_SB(1, 1), cB + hstep + kstep, voffB);
        PG8_WAIT_V(6); PG8_BAR;
    } else {
        PG8_STAGE(PG8_SB(0, 0), cB, voffB); PG8_STAGE(PG8_SA(0, 0), cA, voffA); PG8_STAGE(PG8_SB(0, 1), cB + hstep, voffB); PG8_STAGE(PG8_SA(0, 1), cA + hstep, voffA);
        if (wr == 1) PG8_BAR;
        PG8_WAIT_V(4); PG8_BAR;
        PG8_STAGE(PG8_SB(1, 0), cB + kstep, voffB); PG8_STAGE(PG8_SA(1, 0), cA + kstep, voffA); PG8_STAGE(PG8_SB(1, 1), cB + hstep + kstep, voffB);
        PG8_WAIT_V(6); PG8_BAR;
    }
    for (;;) {
        const bool has_next = S.next(ui + 1, nxt);
        const char* nA = has_next ? (const char*)g.A + (size_t)nxt.pm * tstep : cA; const char* nB = has_next ? (const char*)g.Bt + (size_t)nxt.pn * tstep : cB;
        for (int t = 0; t < nt; t += 2) {
            const bool last = (t == nt - 2);
            const char* a1 = cA + (size_t)(t + 1) * kstep;
            const char* a2 = last ? nA : cA + (size_t)(t + 2) * kstep; const char* b2 = last ? nB : cB + (size_t)(t + 2) * kstep;
            const char* a3 = a2 + kstep; const char* b3 = b2 + kstep;
            if (last && has_next) S.a_ready(nxt);
            if constexpr (SP2) {
            PG8_LDB(B0, 0, 0); PG8_LDB(B1, 0, 1); PG8_SCHED; PG8_LDA(At, 0, 0); PG8_STAGE(PG8_SA(1, 1), a1 + hstep, voffA);
            PG8_WAIT_V(8); PG8_WAIT_L(0); PG8_BAR; PG8_MMA(0, 0, At, B0); PG8_MMA(0, 1, At, B1); PG8_BAR; PG8_SCHED;
            PG8_LDA(At, 0, 1); PG8_STAGE(PG8_SB(0, 0), b2, voffB); PG8_STAGE(PG8_SB(0, 1), b2 + hstep, voffB); PG8_STAGE(PG8_SA(0, 0), a2, voffA);
            PG8_WAIT_V(8); PG8_WAIT_L(0); PG8_BAR; PG8_MMA(1, 0, At, B0); PG8_MMA(1, 1, At, B1); PG8_BAR; PG8_SCHED;
            PG8_LDB(B0, 1, 0); PG8_LDB(B1, 1, 1); PG8_SCHED; PG8_LDA(At, 1, 0); PG8_STAGE(PG8_SA(0, 1), a2 + hstep, voffA);
            PG8_WAIT_V(8); PG8_WAIT_L(0); PG8_BAR; PG8_MMA(0, 0, At, B0); PG8_MMA(0, 1, At, B1); PG8_BAR; PG8_SCHED;
            PG8_LDA(At, 1, 1); PG8_STAGE(PG8_SB(1, 0), b3, voffB); PG8_STAGE(PG8_SB(1, 1), b3 + hstep, voffB); PG8_STAGE(PG8_SA(1, 0), a3, voffA);
            PG8_WAIT_V(8); PG8_WAIT_L(0); PG8_BAR; PG8_MMA(1, 0, At, B0); PG8_MMA(1, 1, At, B1); PG8_BAR; PG8_SCHED;
            } else {
            PG8_LDB(B0, 0, 0); PG8_SCHED; PG8_LDA(At, 0, 0); PG8_STAGE(PG8_SA(1, 1), a1 + hstep, voffA);
            PG8_WAIT_L(8); PG8_BAR; PG8_WAIT_L(0); PG8_MMA(0, 0, At, B0); PG8_BAR; PG8_SCHED;
            PG8_LDB(B1, 0, 1); PG8_STAGE(PG8_SB(0, 0), b2, voffB);
            PG8_BAR; PG8_WAIT_L(0); PG8_MMA(0, 1, At, B1); PG8_BAR;
            PG8_LDA(At, 0, 1); PG8_STAGE(PG8_SA(0, 0), a2, voffA);
            PG8_BAR; PG8_WAIT_L(0); PG8_MMA(1, 0, At, B0); PG8_BAR; PG8_SCHED;
            PG8_STAGE(PG8_SB(0, 1), b2 + hstep, voffB);
            PG8_WAIT_V(6); PG8_BAR; PG8_MMA(1, 1, At, B1); PG8_BAR;
            PG8_LDB(B0, 1, 0); PG8_SCHED; PG8_LDA(At, 1, 0); PG8_STAGE(PG8_SA(0, 1), a2 + hstep, voffA);
            PG8_WAIT_L(8); PG8_BAR; PG8_WAIT_L(0); PG8_MMA(0, 0, At, B0); PG8_BAR; PG8_SCHED;
            PG8_LDB(B1, 1, 1); PG8_STAGE(PG8_SB(1, 0), b3, voffB);
            PG8_BAR; PG8_WAIT_L(0); PG8_MMA(0, 1, At, B1); PG8_BAR;
            PG8_LDA(At, 1, 1); PG8_STAGE(PG8_SA(1, 0), a3, voffA);
            PG8_BAR; PG8_WAIT_L(0); PG8_MMA(1, 0, At, B0); PG8_BAR; PG8_SCHED;
            PG8_STAGE(PG8_SB(1, 1), b3 + hstep, voffB);
            PG8_WAIT_V(6); PG8_BAR; PG8_MMA(1, 1, At, B1); PG8_BAR;
            }
        }
        if constexpr (ALIGN_EPI) { if (wr == 0) PG8_BAR; }
        if constexpr (!Epi::AFTER_DRAIN) { E(acc, cur, wr, wc, fr, fq); S.done(cur); }
        if (!has_next) break;
#pragma unroll
        for (int a = 0; a < 2; ++a)
#pragma unroll
            for (int b = 0; b < 2; ++b)
#pragma unroll
                for (int m = 0; m < 4; ++m)
#pragma unroll
                    for (int n = 0; n < 2; ++n) acc[a][b][m][n] = (f32x4){0.f, 0.f, 0.f, 0.f};
        cur = nxt; cA = nA; cB = nB; ++ui;
        if constexpr (ALIGN_EPI) { if (wr == 1) PG8_BAR; }
    }
    PG8_WAIT_V(0);
    if constexpr (!ALIGN_EPI) { if (wr == 0) PG8_BAR; }
    PG8_BAR;
    if constexpr (Epi::AFTER_DRAIN) { E.fused(acc, cur, wr, wc, fr, fq, lds, wid, lane); S.done(cur); }
#undef PG8_SA
#undef PG8_SB
#undef PG8_STAGE
#undef PG8_LDA
#undef PG8_LDB
#undef PG8_MMA
#undef PG8_WAIT_V
#undef PG8_WAIT_L
#undef PG8_BAR
#undef PG8_SCHED
}
struct EpiG1 {
    static constexpr bool PERM = true, AFTER_DRAIN = false;
    bf16_t* Z; bf16_t* XBC; float* convp;
    __device__ __forceinline__ void operator()(const f32x4 (&acc)[2][2][4][2], const Unit& u, int wr, int wc, int fr, int fq) const {
        const int row0 = u.pm * BM + wr * 64 + fr; int colt = u.pn * BM; bf16_t* base; int ldc; bool isx;
        if (colt < 2048) { base = Z; ldc = 2048; isx = false; } else { base = XBC; ldc = 3072; colt -= 2048; isx = true; }
        const int col0 = colt + wc * 32 + 8 * fq;
#pragma unroll
        for (int ai = 0; ai < 2; ++ai)
#pragma unroll
            for (int m = 0; m < 4; ++m) { const int row = row0 + ai * HALF + m * 16; bf16_t* rowp = base + (size_t)row * ldc + col0;
                const bool tail = isx && ((row & 4095) >= 4093);
#pragma unroll
                for (int bj = 0; bj < 2; ++bj) { const f32x4 v0 = acc[ai][bj][m][0], v1 = acc[ai][bj][m][1];
                    u32x4 w; w.x = cvt_pk_bf16(v0[0], v0[1]); w.y = cvt_pk_bf16(v0[2], v0[3]); w.z = cvt_pk_bf16(v1[0], v1[1]); w.w = cvt_pk_bf16(v1[2], v1[3]);
                    *(u32x4*)(rowp + bj * HALF) = w;
                    if (tail) { float* cp = convp + (size_t)((row >> 12) * 3 + ((row & 4095) - 4093)) * 3072 + col0 + bj * HALF; *(f32x4*)cp = v0; *(f32x4*)(cp + 4) = v1; } } }
    }
};
struct EpiG2 {
    static constexpr bool PERM = false, AFTER_DRAIN = false;
    const float* X; float* H1; bf16_t* H1B; const float* ssqg; float* ssq1;
    __device__ __forceinline__ void operator()(const f32x4 (&acc)[2][2][4][2], const Unit& u, int wr, int wc, int fr, int fq) const {
        const int row0 = u.pm * BM + wr * 64 + fr, col0 = u.pn * BM + wc * 32 + 4 * fq;
#pragma unroll
        for (int ai = 0; ai < 2; ++ai)
#pragma unroll
            for (int m = 0; m < 4; ++m) { const int row = row0 + ai * HALF + m * 16; const size_t off = (size_t)row * 1024 + col0;
                const f32x4 sg = *(const f32x4*)(ssqg + (size_t)row * 4);
                const float rs = __builtin_amdgcn_rsqf(((sg[0] + sg[1]) + (sg[2] + sg[3])) * (1.0f / 2048.0f) + 1e-5f);
                float q = 0.f;
#pragma unroll
                for (int bj = 0; bj < 2; ++bj)
#pragma unroll
                    for (int n = 0; n < 2; ++n) { const f32x4 xv = *(const f32x4*)(X + off + bj * HALF + n * 16); const f32x4 h = xv + acc[ai][bj][m][n] * rs;
                        *(f32x4*)(H1 + off + bj * HALF + n * 16) = h; q += (h[0] * h[0] + h[1] * h[1]) + (h[2] * h[2] + h[3] * h[3]);
                        typedef unsigned u32x2v __attribute__((ext_vector_type(2))); u32x2v w; w.x = cvt_pk_bf16(h[0], h[1]); w.y = cvt_pk_bf16(h[2], h[3]);
                        *(u32x2v*)(H1B + off + bj * HALF + n * 16) = w; }
                q += __shfl_xor(q, 16); q += __shfl_xor(q, 32);
                if (fq == 0) ssq1[(size_t)row * 16 + u.pn * 4 + wc] = q; }
    }
};
struct EpiG3 {
    static constexpr bool PERM = true, AFTER_DRAIN = false;
    const float* ssq1; bf16_t* KB; bf16_t* VB; bf16_t* QB; bf16_t* GS; float* kvp;
    __device__ __forceinline__ void operator()(const f32x4 (&acc)[2][2][4][2], const Unit& u, int wr, int wc, int fr, int fq) const {
        const int row0 = u.pm * BM + wr * 64 + fr; const int colt = u.pn * BM + wc * 32 + 8 * fq;
#pragma unroll
        for (int ai = 0; ai < 2; ++ai)
#pragma unroll
            for (int m = 0; m < 4; ++m) { const int row = row0 + ai * HALF + m * 16; const int b = row >> 12, pos = row & 4095;
                const f32x4* sp = (const f32x4*)(ssq1 + (size_t)row * 16); const f32x4 s0 = sp[0], s1 = sp[1], s2 = sp[2], s3 = sp[3];
                const float ss = ((s0[0] + s0[1]) + (s0[2] + s0[3])) + ((s1[0] + s1[1]) + (s1[2] + s1[3])) + ((s2[0] + s2[1]) + (s2[2] + s2[3])) + ((s3[0] + s3[1]) + (s3[2] + s3[3]));
                const float rs = __builtin_amdgcn_rsqf(ss * (1.0f / 1024.0f) + 1e-5f);
#pragma unroll
                for (int bj = 0; bj < 2; ++bj) { const int col = colt + bj * HALF; f32x4 v0 = acc[ai][bj][m][0] * rs, v1 = acc[ai][bj][m][1] * rs;
                    bf16_t* dst;
                    if (col < 2048) { const int kv = col >> 10, h = (col & 1023) >> 7, d = col & 127;
                        dst = (kv ? VB : KB) + ((size_t)(b * 8 + h) * 4096 + pos) * 128 + d;
                        if (pos >= 2048) { float* kp = kvp + ((size_t)(b * 2048 + (pos - 2048)) * 2 + kv) * 1024 + h * 128 + d; *(f32x4*)kp = v0; *(f32x4*)(kp + 4) = v1; }
                    } else if (col < 5120) { const int qc = col - 2048, g = qc >> 10, h = (qc & 1023) >> 7, d = qc & 127;
                        dst = QB + ((size_t)((b * 3 + g) * 8 + h) * 4096 + pos) * 128 + d;
                        const float sc = 0.08838834764831845f * 1.4426950408889634f; v0 = v0 * sc; v1 = v1 * sc;
                    } else { dst = GS + (size_t)row * 1024 + (col - 5120);
#pragma unroll
                        for (int e = 0; e < 4; ++e) { v0[e] = v0[e] * __builtin_amdgcn_rcpf(1.0f + __builtin_amdgcn_exp2f(-1.4426950408889634f * v0[e])); v1[e] = v1[e] * __builtin_amdgcn_rcpf(1.0f + __builtin_amdgcn_exp2f(-1.4426950408889634f * v1[e])); } }
                    u32x4 w; w.x = cvt_pk_bf16(v0[0], v0[1]); w.y = cvt_pk_bf16(v0[2], v0[3]); w.z = cvt_pk_bf16(v1[0], v1[1]); w.w = cvt_pk_bf16(v1[2], v1[3]);
                    *(u32x4*)dst = w; } }
    }
};
struct EpiG4 {
    static constexpr bool PERM = false, AFTER_DRAIN = false;
    float* H; float* ssq2;
    __device__ __forceinline__ void operator()(const f32x4 (&acc)[2][2][4][2], const Unit& u, int wr, int wc, int fr, int fq) const {
        const int row0 = u.pm * BM + wr * 64 + fr, col0 = u.pn * BM + wc * 32 + 4 * fq;
#pragma unroll
        for (int ai = 0; ai < 2; ++ai)
#pragma unroll
            for (int m = 0; m < 4; ++m) { const int row = row0 + ai * HALF + m * 16; const size_t off = (size_t)row * 1024 + col0; float q = 0.f;
#pragma unroll
                for (int bj = 0; bj < 2; ++bj)
#pragma unroll
                    for (int n = 0; n < 2; ++n) { float* p = H + off + bj * HALF + n * 16; const f32x4 h = *(const f32x4*)p + acc[ai][bj][m][n]; *(f32x4*)p = h;
                        q += (h[0] * h[0] + h[1] * h[1]) + (h[2] * h[2] + h[3] * h[3]); }
                q += __shfl_xor(q, 16); q += __shfl_xor(q, 32);
                if (fq == 0) ssq2[(size_t)row * 16 + u.pn * 4 + wc] = q; }
    }
};
}
constexpr int NWAVES = 8;
constexpr int DM = 1024, NBATCH = 4, SEQ = 4096, MP = NBATCH * SEQ  , SB = 32, ST = 4, MS = SB * ST  ;
constexpr int SI = 2048, CD = 3072, NH = 32, HP = 64, NS = 128, NIN = 5152, NCH = SEQ / 128  ;
constexpr int NKVQ = 6144;
constexpr float EPS = 1e-5f;
constexpr float LOG2E = 1.4426950408889634f, LN2 = 0.6931471805599453f;
enum { I_XP = 0, I_XS, I_SSM, I_CONV, I_CACHE, I_ANORM, I_AWIN, I_ACONVW, I_ACONVB, I_ADTB, I_AALOG, I_AD, I_AGN, I_AWOUT, I_RELB, I_KVN, I_WKV, I_BN, I_BWIN, I_BWOUT, I_FN, N_IN };
constexpr size_t O_YP = 0, O_YS = 16777216, O_SSMP = O_YS + 131072, O_SSMS = O_SSMP + 1048576, O_CONVP = O_SSMS + 8388608, O_CONVS = O_CONVP + 36864, O_KVP = O_CONVS + 294912, O_KVS = O_KVP + 16777216, O_END = O_KVS + 262144;
constexpr size_t MiB = 1u << 20;
constexpr size_t WS_CTL = 0, CTL_ZERO_BYTES = 1 * MiB;
constexpr size_t WS_WIN = 2 * MiB, WS_WOUT = 13 * MiB, WS_WKVQ = 17 * MiB, WS_WBOUT = 29 * MiB;
constexpr size_t WS_XN = 32 * MiB;
constexpr size_t WS_Z = 65 * MiB;
constexpr size_t WS_XBC = 129 * MiB;
constexpr size_t WS_DT = 225 * MiB;
constexpr size_t WS_ACT = 228 * MiB;
constexpr size_t WS_DTV = 324 * MiB, WS_ACS = 326 * MiB;
constexpr size_t WS_CS = 328 * MiB;
constexpr size_t WS_SIN = 456 * MiB;
constexpr size_t WS_YG = 520 * MiB;
constexpr size_t WS_SSQG = 584 * MiB, WS_SSQ1 = 585 * MiB, WS_SSQ2 = 586 * MiB;
constexpr size_t WS_H1B = 587 * MiB;
constexpr size_t WS_KB = 619 * MiB, WS_VB = 651 * MiB, WS_QB = 683 * MiB, WS_GS = 779 * MiB;
constexpr size_t WS_OG = 811 * MiB;
constexpr size_t WS_LSE = 907 * MiB;
constexpr size_t WS_AO = 909 * MiB;
constexpr size_t WS_US = 944 * MiB;
constexpr size_t WS_YGS = 948 * MiB;
constexpr size_t WS_SSQGS = 949 * MiB;
constexpr size_t WS_HS1 = 950 * MiB;
constexpr size_t WS_HS1B = 951 * MiB;
constexpr size_t WS_KVQS = 952 * MiB;
constexpr size_t WS_AOS = 956 * MiB;
constexpr size_t WS_HS2 = 957 * MiB;
constexpr size_t WS_END = 960 * MiB;
constexpr int CW_BAR = 4096;
constexpr int RING_BYTES = 131072;
constexpr int LDS_X_OFF = RING_BYTES, LDS_X_BYTES = 28672;
constexpr int LDSCTL_OFF = LDS_X_OFF + LDS_X_BYTES, MISC_OFF = LDSCTL_OFF + 320;
constexpr int LDS_BYTES = 163840;
static_assert(MISC_OFF + 128 <= LDS_BYTES, "LDS map");
#define GAS __attribute__((address_space(1)))
#define LAS __attribute__((address_space(3)))
typedef unsigned short bf16;
typedef unsigned v4u __attribute__((ext_vector_type(4)));
typedef float f32x4 __attribute__((ext_vector_type(4)));
typedef short bf16x8 __attribute__((ext_vector_type(8)));
typedef GAS unsigned gu32;
typedef GAS unsigned long long gu64;
#define RLX_AGENT __ATOMIC_RELAXED, __HIP_MEMORY_SCOPE_AGENT
#define LDS_WAIT() asm volatile("s_waitcnt lgkmcnt(0)" ::: "memory")
#define VM_WAIT() asm volatile("s_waitcnt vmcnt(0)" ::: "memory")
__device__ __forceinline__ unsigned long long rt() { return __builtin_amdgcn_s_memrealtime(); }
__device__ __forceinline__ unsigned f2bf(float f) { unsigned u = __builtin_bit_cast(unsigned, f); return (u + 0x7fffu + ((u >> 16) & 1u)) >> 16; }
__device__ __forceinline__ unsigned pk2(float lo, float hi) { return f2bf(lo) | (f2bf(hi) << 16); }
__device__ __forceinline__ float wave_sum(float v) {
#pragma unroll
    for (int o = 1; o < 64; o <<= 1) v += __shfl_xor(v, o);
    return v;
}
#define XB_TMO      128
#define XB_XCNT(j)  (256  + 64 * (j))
#define XB_XSUB(j)  (1280 + 64 * (j))
#define XB_XGEN(j)  (2304 + 64 * (j))
#define XB_TOP      3328
#define XB_TOPGEN   3392
#define XCD_BAR_WORDS 3456
#define XB_SPIN_CAP (1u << 18)

__device__ __forceinline__ unsigned xb_ld(unsigned* p)              { return __hip_atomic_load(p, __ATOMIC_RELAXED, __HIP_MEMORY_SCOPE_AGENT); }
__device__ __forceinline__ unsigned xb_add(unsigned* p, unsigned v) { return __hip_atomic_fetch_add(p, v, __ATOMIC_RELAXED, __HIP_MEMORY_SCOPE_AGENT); }
__device__ __forceinline__ unsigned xb_xcc_id() { return (unsigned)__builtin_amdgcn_s_getreg((3 << 11) | 20) & 0xFu; }
#define XB_SPIN(cond, bar) do { unsigned _sp = 0; while (cond) { __builtin_amdgcn_s_sleep(1); \
    if ((++_sp & 255u) == 0u) { if (xb_ld(&(bar)[XB_TMO])) break; if (_sp > XB_SPIN_CAP) { atomicAdd(&(bar)[XB_TMO], 1u); break; } } } } while (0)

struct XcdBarrier {
    unsigned* bar; unsigned x;
    volatile LAS unsigned* st;
};

__device__ __forceinline__ XcdBarrier xcd_barrier_post(unsigned* bar, volatile LAS unsigned* st) {
    XcdBarrier b; b.bar = bar; b.x = xb_xcc_id(); b.st = st;
    if (threadIdx.x == 0) (void)xb_add(&bar[XB_XCNT(b.x)], 1u);
    return b;
}
__device__ __forceinline__ void xcd_barrier_complete(unsigned* bar, unsigned x, unsigned& nloc, unsigned& nx) {
    const unsigned G = gridDim.x * gridDim.y * gridDim.z;
    unsigned sum, cnt, mine, sp = 0u;
    for (;;) {
        sum = 0u; cnt = 0u; mine = 0u;
#pragma unroll
        for (unsigned j = 0; j < 16; ++j) { const unsigned c = xb_ld(&bar[XB_XCNT(j)]); sum += c; cnt += (c > 0u) ? 1u : 0u; mine = (j == x) ? c : mine; }
        if (sum == G) break;
        __builtin_amdgcn_s_sleep(1);
        if ((++sp & 255u) == 0u) { if (xb_ld(&bar[XB_TMO])) break; if (sp > XB_SPIN_CAP) { atomicAdd(&bar[XB_TMO], 1u); break; } }
    }
    nloc = mine > 0u ? mine : 1u; nx = cnt > 0u ? cnt : 1u;
}

__device__ __forceinline__ void xcd_barrier(const XcdBarrier& b) {
    asm volatile("s_waitcnt vmcnt(0)" ::: "memory");
    __syncthreads();
    if (threadIdx.x == 0) {
        unsigned* bar = b.bar;
        __builtin_amdgcn_s_waitcnt(0);
        unsigned nloc = b.st[0], nx = b.st[1];
        if (nloc == 0u) { xcd_barrier_complete(bar, b.x, nloc, nx); b.st[0] = nloc; b.st[1] = nx; }
        const unsigned old = xb_add(&bar[XB_XSUB(b.x)], 1u);
        const unsigned gen = old / nloc;
        if (old + 1u == (gen + 1u) * nloc) {
            __builtin_amdgcn_fence(__ATOMIC_RELEASE, "agent");
            asm volatile("s_waitcnt vmcnt(0)" ::: "memory");
            const unsigned og = xb_add(&bar[XB_TOP], 1u);
            const unsigned tg = og / nx;
            if (og + 1u == (tg + 1u) * nx) xb_add(&bar[XB_TOPGEN], 1u);
            else XB_SPIN(xb_ld(&bar[XB_TOPGEN]) == tg, bar);
            __builtin_amdgcn_fence(__ATOMIC_ACQUIRE, "agent");
            xb_add(&bar[XB_XGEN(b.x)], 1u);
            asm volatile("s_waitcnt vmcnt(0)" ::: "memory");
        } else {
            XB_SPIN(xb_ld(&bar[XB_XGEN(b.x)]) == gen, bar);
            __builtin_amdgcn_fence(__ATOMIC_ACQUIRE, "agent");
            asm volatile("s_waitcnt vmcnt(0)" ::: "memory");
        }
    }
    __syncthreads();
}
typedef float f32x2 __attribute__((ext_vector_type(2)));
typedef short s16x4 __attribute__((ext_vector_type(4)));
typedef unsigned v2u __attribute__((ext_vector_type(2)));
struct Args { const float* in[N_IN]; float* out; unsigned char* ws; int never; int pad; };
struct Frame {
    LAS unsigned char* lds; volatile LAS unsigned* MISC; gu32* ctl;
    int tid, lane, wave, vcu, G, gw, NGW;
    const float* const* in; float* out; unsigned char* ws;
};
__device__ __forceinline__ float bf2f(unsigned short b) { return __builtin_bit_cast(float, (unsigned)b << 16); }
__device__ __forceinline__ float bflo(unsigned u) { return __builtin_bit_cast(float, u << 16); }
__device__ __forceinline__ float bfhi(unsigned u) { return __builtin_bit_cast(float, u & 0xffff0000u); }
__device__ __forceinline__ unsigned cvtpk(float lo, float hi) { unsigned r; asm volatile("v_cvt_pk_bf16_f32 %0, %1, %2" : "=v"(r) : "v"(lo), "v"(hi)); return r; }
__device__ __forceinline__ float fexp2(float x) { return __builtin_amdgcn_exp2f(x); }
__device__ __forceinline__ float fexp(float x) { return __builtin_amdgcn_exp2f(x * LOG2E); }
__device__ __forceinline__ float frcp(float x) { return __builtin_amdgcn_rcpf(x); }
__device__ __forceinline__ float fsilu(float x) { return x * frcp(1.0f + fexp(-x)); }
__device__ __forceinline__ f32x4 mfma16(bf16x8 a, bf16x8 b, f32x4 c) { return __builtin_amdgcn_mfma_f32_16x16x32_bf16(a, b, c, 0, 0, 0); }

__device__ __forceinline__ void p0_transpose_item(const float* W, int K, int N, bf16* WT, int row_off, const float* gk, LAS float* scr, int item, int lane) {
    const int nblk = N / 32, kb = item / nblk, nb = item % nblk, k0 = 64 * kb, n0 = 32 * nb;
#pragma unroll 8
    for (int i = 0; i < 32; ++i) { const int kk = 2 * i + (lane >> 5); float v = W[(size_t)(k0 + kk) * N + n0 + (lane & 31)]; if (gk) v *= gk[k0 + kk]; scr[kk * 33 + (lane & 31)] = v; }
    LDS_WAIT(); asm volatile("" ::: "memory");
    const int c = lane & 7;
#pragma unroll
    for (int j = 0; j < 4; ++j) { const int n = (lane >> 3) + 8 * j; const LAS float* s = scr + (8 * c) * 33 + n;
        v4u o; o.x = pk2(s[0 * 33], s[1 * 33]); o.y = pk2(s[2 * 33], s[3 * 33]); o.z = pk2(s[4 * 33], s[5 * 33]); o.w = pk2(s[6 * 33], s[7 * 33]);
        *(GAS v4u*)(WT + (size_t)(row_off + n0 + n) * K + k0 + 8 * c) = o; }
    LDS_WAIT(); asm volatile("" ::: "memory");
}
__device__ __forceinline__ void rms_row_to_bf16(const float* xrow, const float* g, bf16* orow, int lane) {
    const GAS f32x4* xr = (const GAS f32x4*)xrow + lane; const GAS f32x4* gr = (const GAS f32x4*)g + lane;
    f32x4 v[4]; float s = 0.f;
#pragma unroll
    for (int j = 0; j < 4; ++j) { v[j] = xr[64 * j]; s += (v[j].x * v[j].x + v[j].y * v[j].y) + (v[j].z * v[j].z + v[j].w * v[j].w); }
    const float rstd = __builtin_amdgcn_rsqf(wave_sum(s) * (1.f / 1024.f) + EPS);
    GAS unsigned long long* o8 = (GAS unsigned long long*)orow + lane;
#pragma unroll
    for (int j = 0; j < 4; ++j) { const f32x4 gg = gr[64 * j]; o8[64 * j] = (unsigned long long)pk2(v[j].x * rstd * gg.x, v[j].y * rstd * gg.y) | ((unsigned long long)pk2(v[j].z * rstd * gg.z, v[j].w * rstd * gg.w) << 32); }
}
__device__ __forceinline__ void p0_prologue(Frame& F) {
    LAS float* scr = (LAS float*)(F.lds + F.wave * 16384);
    bf16* WIN = (bf16*)(F.ws + WS_WIN); bf16* WOUT = (bf16*)(F.ws + WS_WOUT); bf16* WKVQ = (bf16*)(F.ws + WS_WKVQ); bf16* WBOUT = (bf16*)(F.ws + WS_WBOUT);
    constexpr int I1 = (1024 / 64) * (NIN / 32), I2 = (2048 / 64) * (1024 / 32), I3 = (1024 / 64) * (2048 / 32), I4 = (1024 / 64) * (4096 / 32), I5 = (1024 / 64) * (1024 / 32);
    constexpr int NITEMS = I1 + I2 + I3 + I4 + I5;
    for (int it = F.gw; it < NITEMS; it += F.NGW) {
        int r = it;
        if (r < I1) { p0_transpose_item(F.in[I_AWIN], 1024, NIN, WIN, 0, nullptr, scr, r, F.lane); continue; } r -= I1;
        if (r < I2) { p0_transpose_item(F.in[I_AWOUT], 2048, 1024, WOUT, 0, F.in[I_AGN], scr, r, F.lane); continue; } r -= I2;
        if (r < I3) { p0_transpose_item(F.in[I_WKV], 1024, 2048, WKVQ, 0, F.in[I_KVN], scr, r, F.lane); continue; } r -= I3;
        if (r < I4) { p0_transpose_item(F.in[I_BWIN], 1024, 4096, WKVQ, 2048, F.in[I_BN], scr, r, F.lane); continue; } r -= I4;
        p0_transpose_item(F.in[I_BWOUT], 1024, 1024, WBOUT, 0, nullptr, scr, r, F.lane);
    }
    bf16* XN = (bf16*)(F.ws + WS_XN);
    for (int m = F.gw; m < MP + MS; m += F.NGW) {
        const float* xr = m < MP ? F.in[I_XP] + (size_t)m * DM : F.in[I_XS] + (size_t)(m - MP) * DM;
        rms_row_to_bf16(xr, F.in[I_ANORM], XN + (size_t)m * DM, F.lane);
    }
}
template <class Fn> __device__ __forceinline__ void wave_tile_gemm(const bf16* A, int lda, const bf16* Bt, int ldb, int K, int m0, int n0, int lane, Fn&& f) {
    const int r16 = lane & 15, g = lane >> 4;
    const bf16* ap = A + (size_t)(m0 + r16) * lda + 8 * g; const bf16* bp = Bt + (size_t)(n0 + r16) * ldb + 8 * g;
    f32x4 acc = {0.f, 0.f, 0.f, 0.f};
    for (int k0 = 0; k0 < K; k0 += 256) {
        bf16x8 a[8], b[8];
#pragma unroll
        for (int i = 0; i < 8; ++i) { a[i] = *(const bf16x8*)(ap + k0 + 32 * i); b[i] = *(const bf16x8*)(bp + k0 + 32 * i); }
#pragma unroll
        for (int i = 0; i < 8; ++i) acc = mfma16(a[i], b[i], acc);
    }
#pragma unroll
    for (int r = 0; r < 4; ++r) f(m0 + 4 * g + r, n0 + r16, acc[r]);
}
__device__ __forceinline__ void p1_small(Frame& F) {
    const bf16* XN = (const bf16*)(F.ws + WS_XN); const bf16* WIN = (const bf16*)(F.ws + WS_WIN);
    float* DT = (float*)(F.ws + WS_DT); float* US = (float*)(F.ws + WS_US);
    constexpr int T1 = (MS / 16) * (NIN / 16), T2 = (MP / 16) * 2;
    for (int t = F.gw; t < T1 + T2; t += F.NGW) {
        if (t < T1) { const int mt = t % (MS / 16), nt = t / (MS / 16);
            wave_tile_gemm(XN + (size_t)MP * DM, DM, WIN, DM, DM, mt * 16, nt * 16, F.lane, [&](int r, int c, float v) { US[(size_t)r * NIN + c] = v; });
        } else { const int q = t - T1, mt = q >> 1, nt = q & 1;
            wave_tile_gemm(XN, DM, WIN + (size_t)5120 * DM, DM, DM, mt * 16, nt * 16, F.lane, [&](int r, int c, float v) { DT[(size_t)r * 32 + c] = v; });
        }
    }
}
constexpr int STR128 = 288, STR64 = 160;
__device__ __forceinline__ s16x4 tr_read(const LAS unsigned char* p) { typedef short v4s __attribute__((ext_vector_type(4))); return __builtin_bit_cast(s16x4, __builtin_amdgcn_ds_read_tr16_b64_v4i16((LAS v4s*)p)); }
__device__ __forceinline__ bf16x8 tr_frag(const LAS unsigned char* tile, int stride, int k0, int m0, int lane) {
    const int g = lane >> 4, q = (lane >> 2) & 3, p = lane & 3;
    const LAS unsigned char* a = tile + (k0 + 4 * g + q) * stride + (m0 + 4 * p) * 2;
    const s16x4 lo = tr_read(a), hi = tr_read(a + 16 * stride);
    return (bf16x8){lo[0], lo[1], lo[2], lo[3], hi[0], hi[1], hi[2], hi[3]};
}
__device__ __forceinline__ int t5_bucket(int n) {
    if (n < 16) return n;
    const int large = 16 + (int)(logf((float)n / 16.0f) / 4.852030263919617f * 16.0f);
    return large < 31 ? large : 31;
}
__device__ __forceinline__ float softplus_f(float x) { return fmaxf(x, 0.f) + log1pf(expf(-fabsf(x))); }
__device__ __forceinline__ void unpack8(const v4u u, float (&f)[8]) { f[0] = bflo(u.x); f[1] = bfhi(u.x); f[2] = bflo(u.y); f[3] = bfhi(u.y); f[4] = bflo(u.z); f[5] = bfhi(u.z); f[6] = bflo(u.w); f[7] = bfhi(u.w); }

__device__ __forceinline__ void conv_cols(const bf16* XBC, bf16* ACT, const float* cw, const float* cb, int R0, int seq_t0, int col, int t0, int nrows,
                                          LAS unsigned char* ldst, int lstride, const LAS float* wscale, const int lmode  ) {
    float w[4][8], bias[8], h0[8], h1[8], h2[8];
#pragma unroll
    for (int k = 0; k < 4; ++k) { const f32x4 a = *(const f32x4*)(cw + k * CD + col), b = *(const f32x4*)(cw + k * CD + col + 4);
        w[k][0] = a[0]; w[k][1] = a[1]; w[k][2] = a[2]; w[k][3] = a[3]; w[k][4] = b[0]; w[k][5] = b[1]; w[k][6] = b[2]; w[k][7] = b[3]; }
    { const f32x4 a = *(const f32x4*)(cb + col), b = *(const f32x4*)(cb + col + 4); bias[0] = a[0]; bias[1] = a[1]; bias[2] = a[2]; bias[3] = a[3]; bias[4] = b[0]; bias[5] = b[1]; bias[6] = b[2]; bias[7] = b[3]; }
#pragma unroll
    for (int e = 0; e < 8; ++e) { h0[e] = 0.f; h1[e] = 0.f; h2[e] = 0.f; }
    if (seq_t0 + t0 - 3 >= 0) unpack8(*(const v4u*)(XBC + (size_t)(R0 + t0 - 3) * CD + col), h0);
    if (seq_t0 + t0 - 2 >= 0) unpack8(*(const v4u*)(XBC + (size_t)(R0 + t0 - 2) * CD + col), h1);
    if (seq_t0 + t0 - 1 >= 0) unpack8(*(const v4u*)(XBC + (size_t)(R0 + t0 - 1) * CD + col), h2);
    for (int t = t0; t < t0 + nrows; ++t) {
        float x[8], a[8]; unpack8(*(const v4u*)(XBC + (size_t)(R0 + t) * CD + col), x);
#pragma unroll
        for (int e = 0; e < 8; ++e) { float c = bias[e] + h0[e] * w[0][e]; c += h1[e] * w[1][e]; c += h2[e] * w[2][e]; c += x[e] * w[3][e]; a[e] = fsilu(c); h0[e] = h1[e]; h1[e] = h2[e]; h2[e] = x[e]; }
        v4u o; o.x = cvtpk(a[0], a[1]); o.y = cvtpk(a[2], a[3]); o.z = cvtpk(a[4], a[5]); o.w = cvtpk(a[6], a[7]);
        if (ACT) *(v4u*)(ACT + (size_t)(R0 + t) * CD + col) = o;
        if (lmode) { if (lmode == 2) { const float s = wscale[t]; o.x = cvtpk(a[0] * s, a[1] * s); o.y = cvtpk(a[2] * s, a[3] * s); o.z = cvtpk(a[4] * s, a[5] * s); o.w = cvtpk(a[6] * s, a[7] * s); }
            *(LAS v4u*)(ldst + t * lstride) = o; }
    }
}

__device__ __forceinline__ void p2_ssd_a(Frame& F) {
    const bf16* XBC = (const bf16*)(F.ws + WS_XBC); bf16* ACT = (bf16*)(F.ws + WS_ACT);
    const float* DT = (const float*)(F.ws + WS_DT); float* DTV = (float*)(F.ws + WS_DTV); float* ACS = (float*)(F.ws + WS_ACS); float* CS = (float*)(F.ws + WS_CS);
    const float* cw = F.in[I_ACONVW]; const float* cb = F.in[I_ACONVB];
    LAS unsigned char* Bt = F.lds;
    LAS unsigned char* Xt = F.lds + 36864;
    LAS float* wtab = (LAS float*)(F.lds + LDS_X_OFF);
    const int lane = F.lane, w = F.wave, tid = F.tid;
    for (int item = F.vcu; item < NBATCH * NCH * 4; item += F.G) {
        const int b = item >> 7, c = (item >> 2) & 31, g = item & 3, R0 = b * SEQ + c * 128, seq0 = c * 128;
        { const int h = 8 * g + w; const float dtb = F.in[I_ADTB][h], a = -expf(F.in[I_AALOG][h]);
          const int s0 = 2 * lane;
          const float d0 = softplus_f(DT[(size_t)(R0 + s0) * 32 + h] + dtb), d1 = softplus_f(DT[(size_t)(R0 + s0 + 1) * 32 + h] + dtb);
          const float a0 = d0 * a, a1 = d1 * a; float v = a0 + a1;
#pragma unroll
          for (int o = 1; o < 64; o <<= 1) { const float t = __shfl_up(v, o); if (lane >= o) v += t; }
          const float c1 = v, c0 = v - a1, cend = __shfl(v, 63);
          DTV[(size_t)(R0 + s0) * 32 + h] = d0; DTV[(size_t)(R0 + s0 + 1) * 32 + h] = d1; ACS[(size_t)(R0 + s0) * 32 + h] = c0; ACS[(size_t)(R0 + s0 + 1) * 32 + h] = c1;
          wtab[w * 128 + s0] = fexp(cend - c0) * d0; wtab[w * 128 + s0 + 1] = fexp(cend - c1) * d1; }
        __syncthreads();
#pragma unroll 1
        for (int pass = 0; pass < 2; ++pass) {
            { int col, t0, nr, lmode, lstride; LAS unsigned char* ld; const LAS float* ws_;
              if (pass == 0) { const int cg = tid & 63, rs = tid >> 6; t0 = 16 * rs; nr = 16;
                  if (cg < 16) { col = 2048 + 128 * g + 8 * cg; ld = Bt + cg * 16; lstride = STR128; ws_ = wtab; lmode = 1; }
                  else if (cg < 32) { col = 2560 + 128 * g + 8 * (cg - 16); ld = Bt; lstride = 0; ws_ = wtab; lmode = 0; }
                  else { const int xc = cg - 32, hh = xc >> 3; col = 512 * g + 8 * xc; ld = Xt + hh * 20480 + (xc & 7) * 16; lstride = STR64; ws_ = wtab + hh * 128; lmode = 2; }
              } else { const int xc = tid & 31, rs = tid >> 5, hh = xc >> 3; t0 = 8 * rs; nr = 8;
                  col = 512 * g + 256 + 8 * xc; ld = Xt + hh * 20480 + (xc & 7) * 16; lstride = STR64; ws_ = wtab + (4 + hh) * 128; lmode = 2; }
              conv_cols(XBC, ACT, cw, cb, R0, seq0, col, t0, nr, ld, lstride, ws_, lmode); }
            __syncthreads();
            const int hh = w & 3, nh = w >> 2, h = 8 * g + 4 * pass + hh;
            f32x4 acc[4][4];
#pragma unroll
            for (int i = 0; i < 4; ++i)
#pragma unroll
                for (int j = 0; j < 4; ++j) acc[i][j] = (f32x4){0.f, 0.f, 0.f, 0.f};
#pragma unroll
            for (int ks = 0; ks < 4; ++ks) { bf16x8 xa[4], bb[4];
#pragma unroll
                for (int mt = 0; mt < 4; ++mt) xa[mt] = tr_frag(Xt + hh * 20480, STR64, 32 * ks, 16 * mt, lane);
#pragma unroll
                for (int nt = 0; nt < 4; ++nt) bb[nt] = tr_frag(Bt, STR128, 32 * ks, 64 * nh + 16 * nt, lane);
#pragma unroll
                for (int nt = 0; nt < 4; ++nt)
#pragma unroll
                    for (int mt = 0; mt < 4; ++mt) acc[nt][mt] = mfma16(bb[nt], xa[mt], acc[nt][mt]); }
            float* cs = CS + ((size_t)((b * NCH + c) * NH + h) * HP) * NS;
#pragma unroll
            for (int nt = 0; nt < 4; ++nt)
#pragma unroll
                for (int mt = 0; mt < 4; ++mt) *(f32x4*)(cs + (size_t)(16 * mt + (lane & 15)) * NS + 64 * nh + 16 * nt + 4 * (lane >> 4)) = acc[nt][mt];
            __syncthreads();
        }
    }
}

__device__ __forceinline__ void p2_sample(Frame& F) {
    const float* US = (const float*)(F.ws + WS_US); bf16* YGS = (bf16*)(F.ws + WS_YGS); float* SSQGS = (float*)(F.ws + WS_SSQGS);
    const float* cw = F.in[I_ACONVW]; const float* cb = F.in[I_ACONVB]; const float* sconv = F.in[I_CONV]; const float* sssm = F.in[I_SSM];
    LAS float* L = (LAS float*)F.lds;
    const int lane = F.lane, w = F.wave, tid = F.tid;
    for (int item = F.vcu; item < SB * NH; item += F.G) {
        const int sb = item >> 5, h = item & 31, g = h >> 3;
        if (tid < 320) { const int col = tid < 64 ? h * 64 + tid : (tid < 192 ? 2048 + g * 128 + (tid - 64) : 2560 + g * 128 + (tid - 192));
            float xc[7];
#pragma unroll
            for (int k = 0; k < 3; ++k) xc[k] = sconv[((size_t)sb * 3 + k) * CD + col];
#pragma unroll
            for (int t = 0; t < 4; ++t) xc[3 + t] = US[(size_t)(sb * 4 + t) * NIN + 2048 + col];
            const float w0 = cw[col], w1 = cw[CD + col], w2 = cw[2 * CD + col], w3 = cw[3 * CD + col], bb = cb[col];
#pragma unroll
            for (int t = 0; t < 4; ++t) { const float cv = bb + xc[t] * w0 + xc[t + 1] * w1 + xc[t + 2] * w2 + xc[t + 3] * w3; const float a = fsilu(cv);
                if (tid < 64) L[t * 64 + tid] = a; else if (tid < 192) L[256 + t * 128 + (tid - 64)] = a; else L[768 + t * 128 + (tid - 192)] = a; }
        } else if (tid < 324) { const int t = tid - 320; const float d = softplus_f(US[(size_t)(sb * 4 + t) * NIN + 5120 + h] + F.in[I_ADTB][h]);
            L[1280 + t] = d; L[1284 + t] = expf(d * (-expf(F.in[I_AALOG][h]))); }
        if (h == 0) { float* cs = F.out + O_CONVS + (size_t)sb * 3 * CD;
            for (int e = tid; e < 3 * CD; e += NWAVES * 64) { const int j = e / CD, col = e - j * CD; cs[e] = US[(size_t)(sb * 4 + 1 + j) * NIN + 2048 + col]; } }
        __syncthreads();
        const float Dh = F.in[I_AD][h];
        float ssq[4] = {0.f, 0.f, 0.f, 0.f};
#pragma unroll 2
        for (int pp = 0; pp < 8; ++pp) { const int p = 8 * w + pp;
            const float* sp = sssm + ((size_t)(sb * NH + h) * HP + p) * NS + 2 * lane; f32x2 s = *(const f32x2*)sp;
#pragma unroll
            for (int t = 0; t < 4; ++t) { const float dA = L[1284 + t], xd = L[1280 + t] * L[t * 64 + p];
                const f32x2 bv = *(const LAS f32x2*)(L + 256 + t * 128 + 2 * lane), cv = *(const LAS f32x2*)(L + 768 + t * 128 + 2 * lane);
                s.x = dA * s.x + xd * bv.x; s.y = dA * s.y + xd * bv.y;
                float y = wave_sum(cv.x * s.x + cv.y * s.y);
                y += Dh * L[t * 64 + p];
                const int row = sb * 4 + t; const float z = US[(size_t)row * NIN + h * 64 + p]; const float yg = y * fsilu(z);
                ssq[t] += yg * yg;
                if (lane == 0) YGS[(size_t)row * SI + h * 64 + p] = (bf16)f2bf(yg); }
            *(f32x2*)(F.out + O_SSMS + ((size_t)(sb * NH + h) * HP + p) * NS + 2 * lane) = s; }
        if (lane == 0) {
#pragma unroll
            for (int t = 0; t < 4; ++t) L[1296 + w * 4 + t] = ssq[t]; }
        __syncthreads();
        if (tid < 4) { float q = 0.f;
#pragma unroll
            for (int ww = 0; ww < 8; ++ww) q += L[1296 + ww * 4 + tid];
            SSQGS[(size_t)(sb * 4 + tid) * 32 + h] = q; }
        __syncthreads();
    }
}

__device__ __forceinline__ void p3_scan(Frame& F) {
    const float* CS = (const float*)(F.ws + WS_CS); const float* ACS = (const float*)(F.ws + WS_ACS); bf16* SIN = (bf16*)(F.ws + WS_SIN);
    const int gt = F.vcu * (NWAVES * 64) + F.tid, NT = F.G * NWAVES * 64;
    for (int e = gt; e < NBATCH * NH * HP * NS / 4; e += NT) {
        const int n4 = e & 31, p = (e >> 5) & 63, h = (e >> 11) & 31, b = e >> 16;
        f32x4 s = {0.f, 0.f, 0.f, 0.f};
#pragma unroll 8
        for (int c = 0; c < NCH; ++c) { const size_t off = (((size_t)(b * NCH + c) * NH + h) * HP + p) * NS + 4 * n4;
            v2u o; o.x = cvtpk(s[0], s[1]); o.y = cvtpk(s[2], s[3]); *(v2u*)(SIN + off) = o;
            const float dec = fexp(ACS[(size_t)(b * SEQ + c * 128 + 127) * 32 + h]); const f32x4 cs = *(const f32x4*)(CS + off);
            s = s * dec + cs; }
        *(f32x4*)(F.out + O_SSMP + (((size_t)(b * NH + h)) * HP + p) * NS + 4 * n4) = s;
    }
}
__device__ __forceinline__ void p4_ssd_b(Frame& F) {
    const bf16* ACT = (const bf16*)(F.ws + WS_ACT); const bf16* Z = (const bf16*)(F.ws + WS_Z); const bf16* SIN = (const bf16*)(F.ws + WS_SIN);
    const float* DTV = (const float*)(F.ws + WS_DTV); const float* ACS = (const float*)(F.ws + WS_ACS); bf16* YG = (bf16*)(F.ws + WS_YG); float* SSQG = (float*)(F.ws + WS_SSQG);
    LAS unsigned char* Xt = F.lds;
    const int lane = F.lane, w = F.wave, tid = F.tid, i = lane & 15, gq = lane >> 4;
    LAS float* stg = (LAS float*)(F.lds + 81920 + w * 4352);
    LAS float* acsT = (LAS float*)(F.lds + LDS_X_OFF); LAS float* dtvT = acsT + 1024;
    for (int item = F.vcu; item < NBATCH * NCH * 4; item += F.G) {
        const int b = item >> 7, c = (item >> 2) & 31, g = item & 3, R0 = b * SEQ + c * 128;
        for (int e = tid; e < 1024; e += NWAVES * 64) { const int h8 = e >> 7, s = e & 127; acsT[e] = ACS[(size_t)(R0 + s) * 32 + 8 * g + h8]; dtvT[e] = DTV[(size_t)(R0 + s) * 32 + 8 * g + h8]; }
        bf16x8 cf[4];
#pragma unroll
        for (int kn = 0; kn < 4; ++kn) cf[kn] = *(const bf16x8*)(ACT + (size_t)(R0 + 16 * w + i) * CD + 2560 + 128 * g + 32 * kn + 8 * gq);
        f32x4 cbt[8];
#pragma unroll
        for (int st = 0; st < 8; ++st) { f32x4 a = {0.f, 0.f, 0.f, 0.f};
            if (st <= w) {
#pragma unroll
                for (int kn = 0; kn < 4; ++kn) { const bf16x8 bf = *(const bf16x8*)(ACT + (size_t)(R0 + 16 * st + i) * CD + 2048 + 128 * g + 32 * kn + 8 * gq); a = mfma16(bf, cf[kn], a); } }
            cbt[st] = a; }
        float ssq = 0.f;
        const int tr = lane >> 2, pc = lane & 3;
#pragma unroll 1
        for (int pass = 0; pass < 2; ++pass) {
            for (int e = tid; e < 4096; e += NWAVES * 64) { const int s = e >> 5, cc = e & 31;
                *(LAS v4u*)(Xt + (cc >> 3) * 20480 + s * STR64 + (cc & 7) * 16) = *(const v4u*)(ACT + (size_t)(R0 + s) * CD + 512 * g + 256 * pass + 8 * cc); }
            __syncthreads();
#pragma unroll 1
            for (int hh = 0; hh < 4; ++hh) { const int hl = 4 * pass + hh, h = 8 * g + hl;
                const LAS unsigned char* Xh = Xt + hh * 20480;
                const float ea_t = acsT[hl * 128 + 16 * w + i];
                bf16x8 lf[4];
#pragma unroll
                for (int ks = 0; ks < 4; ++ks) { float v[8];
#pragma unroll
                    for (int half = 0; half < 2; ++half) { const int st = 2 * ks + half;
                        if (st <= w) { const f32x4 a4 = *(const LAS f32x4*)(acsT + hl * 128 + 16 * st + 4 * gq), d4 = *(const LAS f32x4*)(dtvT + hl * 128 + 16 * st + 4 * gq);
#pragma unroll
                            for (int r = 0; r < 4; ++r) { float x = cbt[st][r] * fexp(ea_t - a4[r]) * d4[r]; if (st == w && 4 * gq + r > i) x = 0.f; v[4 * half + r] = x; }
                        } else {
#pragma unroll
                            for (int r = 0; r < 4; ++r) v[4 * half + r] = 0.f; } }
                    v4u pk; pk.x = cvtpk(v[0], v[1]); pk.y = cvtpk(v[2], v[3]); pk.z = cvtpk(v[4], v[5]); pk.w = cvtpk(v[6], v[7]); lf[ks] = __builtin_bit_cast(bf16x8, pk); }
                f32x4 yd[4], yo[4];
#pragma unroll
                for (int pt = 0; pt < 4; ++pt) { yd[pt] = (f32x4){0.f, 0.f, 0.f, 0.f}; yo[pt] = (f32x4){0.f, 0.f, 0.f, 0.f}; }
#pragma unroll
                for (int ks = 0; ks < 4; ++ks) if (2 * ks <= w) {
#pragma unroll
                    for (int pt = 0; pt < 4; ++pt) { const bf16x8 xb = tr_frag(Xh, STR64, 32 * ks, 16 * pt, lane); yd[pt] = mfma16(lf[ks], xb, yd[pt]); } }
                const bf16* sp = SIN + ((size_t)((b * NCH + c) * NH + h) * HP + i) * NS + 8 * gq;
#pragma unroll
                for (int kn = 0; kn < 4; ++kn)
#pragma unroll
                    for (int pt = 0; pt < 4; ++pt) { const bf16x8 sf = *(const bf16x8*)(sp + (size_t)(16 * pt) * NS + 32 * kn); yo[pt] = mfma16(cf[kn], sf, yo[pt]); }
                const f32x4 ea4 = *(const LAS f32x4*)(acsT + hl * 128 + 16 * w + 4 * gq);
#pragma unroll
                for (int r = 0; r < 4; ++r) { const float er = fexp(ea4[r]);
#pragma unroll
                    for (int pt = 0; pt < 4; ++pt) stg[(4 * gq + r) * 68 + 16 * pt + i] = yd[pt][r] + er * yo[pt][r]; }
                const int row = R0 + 16 * w + tr; const float Dh = F.in[I_AD][h];
                float y[16], x[16], z[16];
#pragma unroll
                for (int q = 0; q < 4; ++q) { const f32x4 t4 = *(const LAS f32x4*)(stg + tr * 68 + 16 * pc + 4 * q); y[4 * q] = t4[0]; y[4 * q + 1] = t4[1]; y[4 * q + 2] = t4[2]; y[4 * q + 3] = t4[3]; }
                { const LAS v4u* xp = (const LAS v4u*)(Xh + (16 * w + tr) * STR64 + pc * 32); float t8[8]; unpack8(xp[0], t8);
#pragma unroll
                  for (int e = 0; e < 8; ++e) x[e] = t8[e];
                  unpack8(xp[1], t8);
#pragma unroll
                  for (int e = 0; e < 8; ++e) x[8 + e] = t8[e]; }
                { const v4u* zp = (const v4u*)(Z + (size_t)row * SI + h * 64 + 16 * pc); float t8[8]; unpack8(zp[0], t8);
#pragma unroll
                  for (int e = 0; e < 8; ++e) z[e] = t8[e];
                  unpack8(zp[1], t8);
#pragma unroll
                  for (int e = 0; e < 8; ++e) z[8 + e] = t8[e]; }
#pragma unroll
                for (int e = 0; e < 16; ++e) { const float yy = (y[e] + Dh * x[e]) * fsilu(z[e]); y[e] = yy; ssq += yy * yy; }
                v4u o0, o1; o0.x = cvtpk(y[0], y[1]); o0.y = cvtpk(y[2], y[3]); o0.z = cvtpk(y[4], y[5]); o0.w = cvtpk(y[6], y[7]); o1.x = cvtpk(y[8], y[9]); o1.y = cvtpk(y[10], y[11]); o1.z = cvtpk(y[12], y[13]); o1.w = cvtpk(y[14], y[15]);
                v4u* op = (v4u*)(YG + (size_t)row * SI + h * 64 + 16 * pc); op[0] = o0; op[1] = o1;
            }
            __syncthreads();
        }
        ssq += __shfl_xor(ssq, 1); ssq += __shfl_xor(ssq, 2);
        if (pc == 0) SSQG[(size_t)(R0 + 16 * w + tr) * 4 + g] = ssq;
    }
}

__device__ __forceinline__ f32x4 wave_tile_gemm_ss(const bf16* A, int lda, const bf16* Bt, int ldb, int K, int m0, int n0, int lane, float& ss) {
    const int r16 = lane & 15, g = lane >> 4;
    const bf16* ap = A + (size_t)(m0 + r16) * lda + 8 * g; const bf16* bp = Bt + (size_t)(n0 + r16) * ldb + 8 * g;
    f32x4 acc = {0.f, 0.f, 0.f, 0.f}; float q = 0.f;
    for (int k0 = 0; k0 < K; k0 += 256) {
        bf16x8 a[8], b[8];
#pragma unroll
        for (int i = 0; i < 8; ++i) { a[i] = *(const bf16x8*)(ap + k0 + 32 * i); b[i] = *(const bf16x8*)(bp + k0 + 32 * i); }
#pragma unroll
        for (int i = 0; i < 8; ++i) { acc = mfma16(a[i], b[i], acc); float t8[8]; unpack8(__builtin_bit_cast(v4u, a[i]), t8);
#pragma unroll
            for (int e = 0; e < 8; ++e) q += t8[e] * t8[e]; }
    }
    q += __shfl_xor(q, 16); q += __shfl_xor(q, 32); ss = q; return acc;
}
__device__ __forceinline__ void p3_sample(Frame& F) {
    const bf16* YGS = (const bf16*)(F.ws + WS_YGS); const bf16* WOUT = (const bf16*)(F.ws + WS_WOUT); const float* SSQGS = (const float*)(F.ws + WS_SSQGS);
    float* HS1 = (float*)(F.ws + WS_HS1); bf16* HS1B = (bf16*)(F.ws + WS_HS1B); const float* xs = F.in[I_XS];
    for (int t = F.gw; t < (MS / 16) * (DM / 16); t += F.NGW) { const int mt = t & 7, nt = t >> 3; const int lane = F.lane, gq = lane >> 4;
        float rs[4];
#pragma unroll
        for (int r = 0; r < 4; ++r) { const f32x4* sp = (const f32x4*)(SSQGS + (size_t)(mt * 16 + 4 * gq + r) * 32); float q = 0.f;
#pragma unroll
            for (int k = 0; k < 8; ++k) { const f32x4 v = sp[k]; q += (v[0] + v[1]) + (v[2] + v[3]); }
            rs[r] = __builtin_amdgcn_rsqf(q * (1.f / 2048.f) + EPS); }
        int rr = 0;
        wave_tile_gemm(YGS, SI, WOUT, SI, SI, mt * 16, nt * 16, lane, [&](int r, int c, float v) { const float h = xs[(size_t)r * DM + c] + v * rs[rr]; ++rr; HS1[(size_t)r * DM + c] = h; HS1B[(size_t)r * DM + c] = (bf16)f2bf(h); });
    }
}
__device__ __forceinline__ void p4_sample(Frame& F) {
    const bf16* HS1B = (const bf16*)(F.ws + WS_HS1B); const bf16* WKVQ = (const bf16*)(F.ws + WS_WKVQ); float* KVQS = (float*)(F.ws + WS_KVQS);
    for (int t = F.gw; t < (MS / 16) * (NKVQ / 16); t += F.NGW) { const int mt = t & 7, nt = t >> 3; const int lane = F.lane, gq = lane >> 4, i = lane & 15;
        float ss; const f32x4 acc = wave_tile_gemm_ss(HS1B, DM, WKVQ, DM, DM, mt * 16, nt * 16, lane, ss);
        const float rsl = __builtin_amdgcn_rsqf(ss * (1.f / 1024.f) + EPS);
#pragma unroll
        for (int r = 0; r < 4; ++r) { const float rs = __shfl(rsl, 4 * gq + r); const int row = mt * 16 + 4 * gq + r, col = nt * 16 + i; const float v = acc[r] * rs;
            KVQS[(size_t)row * NKVQ + col] = v; if (col < 2048) F.out[O_KVS + (size_t)row * 2048 + col] = v; }
    }
}
__device__ __forceinline__ void p5_sample_attn(Frame& F) {
    const float* KVQS = (const float*)(F.ws + WS_KVQS); const float* cache = F.in[I_CACHE]; bf16* AOS = (bf16*)(F.ws + WS_AOS);
    LAS float* qv = (LAS float*)F.lds; LAS float* sc = qv + 1536; LAS float* bt = sc + 1584; LAS float* lse = bt + 396; LAS float* po = lse + 16;
    const int lane = F.lane, w = F.wave, tid = F.tid;
    for (int item = F.vcu; item < SB * 8; item += F.G) { const int sb = item >> 3, h = item & 7;
        __syncthreads();
        for (int e = tid; e < 1536; e += NWAVES * 64) { const int pr = e >> 7, d = e & 127, g = pr >> 2, t = pr & 3;
            qv[e] = KVQS[(size_t)(sb * 4 + t) * NKVQ + 2048 + g * 1024 + h * 128 + d] * 0.08838834764831845f; }
        for (int e = tid; e < 3 * 129; e += NWAVES * 64) { const int g = e / 129, j = e - g * 129, dil = g == 0 ? 1 : (g == 1 ? 4 : 16);
            bt[g * 132 + j] = F.in[I_RELB][t5_bucket(j * dil) * 24 + g * 8 + h]; }
        __syncthreads();
        const int lg = lane >> 3, sub = lane & 7;
        for (int it = 0; it < 25; ++it) { const int combo = it * 64 + w * 8 + lg, cc = combo < 1548 ? combo : 1547, pr = cc / 129, j = cc - pr * 129, g = pr >> 2, t = pr & 3;
            const int dil = g == 0 ? 1 : (g == 1 ? 4 : 16), idx = 2048 + t - dil * j;
            const float* kr = idx >= 2048 ? KVQS + (size_t)(sb * 4 + idx - 2048) * NKVQ + h * 128 : cache + ((size_t)(sb * 2048 + idx) * 2) * 1024 + h * 128;
            float dot = 0.f;
#pragma unroll
            for (int k = 0; k < 4; ++k) { const f32x4 kv = *(const f32x4*)(kr + 4 * (sub + 8 * k)); const f32x4 q4 = *(const LAS f32x4*)(qv + pr * 128 + 4 * (sub + 8 * k));
                dot += (kv[0] * q4[0] + kv[1] * q4[1]) + (kv[2] * q4[2] + kv[3] * q4[3]); }
            dot += __shfl_xor(dot, 1); dot += __shfl_xor(dot, 2); dot += __shfl_xor(dot, 4);
            if (sub == 0 && combo < 1548) sc[pr * 132 + j] = dot + bt[g * 132 + j]; }
        __syncthreads();
        for (int pr = w; pr < 12; pr += 8) { const float s0 = sc[pr * 132 + lane], s1 = sc[pr * 132 + 64 + lane], s2 = lane == 0 ? sc[pr * 132 + 128] : -1e30f;
            float m = fmaxf(s0, fmaxf(s1, s2));
#pragma unroll
            for (int o = 1; o < 64; o <<= 1) m = fmaxf(m, __shfl_xor(m, o));
            const float e0 = fexp(s0 - m), e1 = fexp(s1 - m), e2 = lane == 0 ? fexp(s2 - m) : 0.f; const float l = wave_sum(e0 + e1 + e2), rl = frcp(l);
            sc[pr * 132 + lane] = e0 * rl; sc[pr * 132 + 64 + lane] = e1 * rl; if (lane == 0) { sc[pr * 132 + 128] = e2 * rl; lse[pr] = m + __builtin_amdgcn_logf(l) * LN2; } }
        __syncthreads();
        f32x2 acc[12];
#pragma unroll
        for (int pr = 0; pr < 12; ++pr) { const int g = pr >> 2, t = pr & 3, dil = g == 0 ? 1 : (g == 1 ? 4 : 16); f32x2 a = {0.f, 0.f};
#pragma unroll 4
            for (int j = w; j < 129; j += 8) { const int idx = 2048 + t - dil * j;
                const float* vr = idx >= 2048 ? KVQS + (size_t)(sb * 4 + idx - 2048) * NKVQ + 1024 + h * 128 : cache + ((size_t)(sb * 2048 + idx) * 2 + 1) * 1024 + h * 128;
                const f32x2 v = *(const f32x2*)(vr + 2 * lane); const float p = sc[pr * 132 + j]; a.x += p * v.x; a.y += p * v.y; }
            acc[pr] = a; }
#pragma unroll
        for (int pr = 0; pr < 12; ++pr) *(LAS f32x2*)(po + (w * 12 + pr) * 128 + 2 * lane) = acc[pr];
        __syncthreads();
        { const int t = tid >> 7, d = tid & 127; float og[3], lg3[3];
#pragma unroll
          for (int g = 0; g < 3; ++g) { const int pr = g * 4 + t; float s = 0.f;
#pragma unroll
              for (int ww = 0; ww < 8; ++ww) s += po[(ww * 12 + pr) * 128 + d];
              og[g] = s; lg3[g] = lse[pr]; }
          const float m = fmaxf(lg3[0], fmaxf(lg3[1], lg3[2])); const float w0 = fexp(lg3[0] - m), w1 = fexp(lg3[1] - m), w2 = fexp(lg3[2] - m);
          const float o = (w0 * og[0] + w1 * og[1] + w2 * og[2]) * frcp(w0 + w1 + w2);
          const int row = sb * 4 + t; const float gate = KVQS[(size_t)row * NKVQ + 5120 + h * 128 + d];
          AOS[(size_t)row * DM + h * 128 + d] = (bf16)f2bf(o * fsilu(gate)); }
    }
}
__device__ __forceinline__ void p6_sample(Frame& F) {
    const bf16* AOS = (const bf16*)(F.ws + WS_AOS); const bf16* WB = (const bf16*)(F.ws + WS_WBOUT); const float* HS1 = (const float*)(F.ws + WS_HS1); float* HS2 = (float*)(F.ws + WS_HS2);
    for (int t = F.gw; t < (MS / 16) * (DM / 16); t += F.NGW) { const int mt = t & 7, nt = t >> 3;
        wave_tile_gemm(AOS, DM, WB, DM, DM, mt * 16, nt * 16, F.lane, [&](int r, int c, float v) { HS2[(size_t)r * DM + c] = HS1[(size_t)r * DM + c] + v; });
    }
}
constexpr int KSTR = 272, VSTR = 288, ATT_K0 = 0, ATT_V0 = 2 * 128 * KSTR  , ATT_BT = ATT_V0 + 2 * 128 * VSTR  ;
static_assert(ATT_BT + 132 * 4 <= LDSCTL_OFF, "attention LDS map");
__device__ __forceinline__ void attn_load_half(Frame& F, const bf16* Kh, const bf16* Vh, int m, int res, int dil) {
    LAS unsigned char* kb = F.lds + ATT_K0 + (m & 1) * (128 * KSTR); LAS unsigned char* vb = F.lds + ATT_V0 + (m & 1) * (128 * VSTR);
#pragma unroll
    for (int k = 0; k < 4; ++k) { const int e = F.tid + 512 * k, kr = e >> 4, ch = e & 15;
        v4u kv = {0u, 0u, 0u, 0u}, vv = {0u, 0u, 0u, 0u};
        if (m >= 0) { const size_t off = (size_t)(res + dil * (128 * m + kr)) * 128 + 8 * ch; kv = *(const v4u*)(Kh + off); vv = *(const v4u*)(Vh + off); }
        *(LAS v4u*)(kb + kr * KSTR + ch * 16) = kv; *(LAS v4u*)(vb + kr * VSTR + ch * 16) = vv; }
}
__device__ __forceinline__ void attn_stream(Frame& F, int b, int g, int h, int res, int dil, int n0, int n1) {
    const bf16* Kh = (const bf16*)(F.ws + WS_KB) + (size_t)(b * 8 + h) * 4096 * 128; const bf16* Vh = (const bf16*)(F.ws + WS_VB) + (size_t)(b * 8 + h) * 4096 * 128;
    const bf16* Qh = (const bf16*)(F.ws + WS_QB) + (size_t)((b * 3 + g) * 8 + h) * 4096 * 128;
    bf16* OG = (bf16*)(F.ws + WS_OG) + (size_t)g * MP * 1024; float* LSE = (float*)(F.ws + WS_LSE) + (size_t)g * MP * 8;
    LAS float* bt = (LAS float*)(F.lds + ATT_BT);
    const int lane = F.lane, w = F.wave, i = lane & 15, gq = lane >> 4;
    __syncthreads();
    if (F.tid <= 128) bt[F.tid] = F.in[I_RELB][t5_bucket(F.tid * dil) * 24 + g * 8 + h] * LOG2E;
    attn_load_half(F, Kh, Vh, n0 - 1, res, dil);
    for (int n = n0; n < n1; ++n) {
        attn_load_half(F, Kh, Vh, n, res, dil);
        __syncthreads();
        const int posq = res + dil * (128 * n + 16 * w + i);
        bf16x8 qf[4];
#pragma unroll
        for (int s = 0; s < 4; ++s) qf[s] = *(const bf16x8*)(Qh + (size_t)posq * 128 + 32 * s + 8 * gq);
        f32x4 sc[9]; float mx = -1e30f;
#pragma unroll
        for (int dk = 0; dk < 9; ++dk) { const int kt = w + dk; f32x4 a = {0.f, 0.f, 0.f, 0.f};
            if (n > 0 || kt >= 8) {
                const LAS unsigned char* kp = F.lds + ATT_K0 + ((n - 1 + (kt >> 3)) & 1) * (128 * KSTR) + ((kt & 7) * 16 + i) * KSTR + 16 * gq;
#pragma unroll
                for (int s = 0; s < 4; ++s) a = mfma16(*(const LAS bf16x8*)(kp + 64 * s), qf[s], a);
#pragma unroll
                for (int r = 0; r < 4; ++r) { const int kk = 4 * gq + r, rel = 128 + i - 16 * dk - kk; float v = a[r] + bt[rel < 0 ? 0 : (rel > 128 ? 128 : rel)];
                    if ((dk == 0 && kk < i) || (dk == 8 && kk > i)) v = -1e30f; a[r] = v; mx = fmaxf(mx, v); }
            } else { a = (f32x4){-1e30f, -1e30f, -1e30f, -1e30f}; }
            sc[dk] = a; }
        mx = fmaxf(mx, __shfl_xor(mx, 16)); mx = fmaxf(mx, __shfl_xor(mx, 32));
        float l = 0.f;
#pragma unroll
        for (int dk = 0; dk < 9; ++dk)
#pragma unroll
            for (int r = 0; r < 4; ++r) { const float p = fexp2(sc[dk][r] - mx); sc[dk][r] = p; l += p; }
        l += __shfl_xor(l, 16); l += __shfl_xor(l, 32);
        const float rl = frcp(l);
        bf16x8 pf[5];
#pragma unroll
        for (int ks = 0; ks < 5; ++ks) { v4u pk; pk.x = cvtpk(sc[2 * ks][0] * rl, sc[2 * ks][1] * rl); pk.y = cvtpk(sc[2 * ks][2] * rl, sc[2 * ks][3] * rl);
            if (ks < 4) { pk.z = cvtpk(sc[2 * ks + 1][0] * rl, sc[2 * ks + 1][1] * rl); pk.w = cvtpk(sc[2 * ks + 1][2] * rl, sc[2 * ks + 1][3] * rl); } else { pk.z = 0u; pk.w = 0u; }
            pf[ks] = __builtin_bit_cast(bf16x8, pk); }
        f32x4 o[8];
#pragma unroll
        for (int dt = 0; dt < 8; ++dt) o[dt] = (f32x4){0.f, 0.f, 0.f, 0.f};
        const int q4 = (lane >> 2) & 3, p4 = lane & 3;
#pragma unroll
        for (int ks = 0; ks < 5; ++ks) { const int kt0 = w + 2 * ks, kt1 = (ks < 4) ? kt0 + 1 : kt0;
            const LAS unsigned char* v0 = F.lds + ATT_V0 + ((n - 1 + (kt0 >> 3)) & 1) * (128 * VSTR) + ((kt0 & 7) * 16 + 4 * gq + q4) * VSTR + 8 * p4;
            const LAS unsigned char* v1 = F.lds + ATT_V0 + ((n - 1 + (kt1 >> 3)) & 1) * (128 * VSTR) + ((kt1 & 7) * 16 + 4 * gq + q4) * VSTR + 8 * p4;
#pragma unroll
            for (int dt = 0; dt < 8; ++dt) { const s16x4 lo = tr_read(v0 + 32 * dt), hi = tr_read(v1 + 32 * dt);
                const bf16x8 vf = (bf16x8){lo[0], lo[1], lo[2], lo[3], hi[0], hi[1], hi[2], hi[3]}; o[dt] = mfma16(vf, pf[ks], o[dt]); } }
        const size_t tok = (size_t)b * SEQ + posq; bf16* op = OG + tok * 1024 + h * 128 + 4 * gq;
#pragma unroll
        for (int dt = 0; dt < 8; ++dt) { v2u pk; pk.x = cvtpk(o[dt][0], o[dt][1]); pk.y = cvtpk(o[dt][2], o[dt][3]); *(v2u*)(op + 16 * dt) = pk; }
        if (gq == 0) LSE[tok * 8 + h] = (mx + __builtin_amdgcn_logf(l)) * LN2;
        __syncthreads();
    }
}
__device__ __forceinline__ void p7_attention(Frame& F) {
    for (int u = F.vcu; u < 768; u += F.G) { const int g = u >> 8, v = u & 255, b = v >> 6, h = (v >> 3) & 7;
        if (g == 0) { const int seg = v & 7; attn_stream(F, b, 0, h, 0, 1, 4 * seg, 4 * seg + 4); }
        else if (g == 1) { const int res = (v >> 1) & 3, seg = v & 1; attn_stream(F, b, 1, h, res, 4, 4 * seg, 4 * seg + 4); }
        else { const int rp = v & 7; attn_stream(F, b, 2, h, 2 * rp, 16, 0, 2); attn_stream(F, b, 2, h, 2 * rp + 1, 16, 0, 2); }
    }
}
__device__ __forceinline__ void p8_combine(Frame& F) {
    const bf16* OG = (const bf16*)(F.ws + WS_OG); const float* LSE = (const float*)(F.ws + WS_LSE); const bf16* GS = (const bf16*)(F.ws + WS_GS); bf16* AO = (bf16*)(F.ws + WS_AO);
    const int gt = F.vcu * (NWAVES * 64) + F.tid, NT = F.G * NWAVES * 64;
    for (int e = gt; e < MP * 128; e += NT) { const int row = e >> 7, c8 = e & 127, h = c8 >> 4;
        const float l0 = LSE[(size_t)row * 8 + h], l1 = LSE[(size_t)(MP + row) * 8 + h], l2 = LSE[(size_t)(2 * MP + row) * 8 + h];
        const float m = fmaxf(l0, fmaxf(l1, l2)); float w0 = fexp(l0 - m), w1 = fexp(l1 - m), w2 = fexp(l2 - m); const float rs = frcp(w0 + w1 + w2); w0 *= rs; w1 *= rs; w2 *= rs;
        float a[8], t[8], gsv[8]; const size_t off = (size_t)row * 1024 + 8 * c8;
        unpack8(*(const v4u*)(OG + off), a);
#pragma unroll
        for (int k = 0; k < 8; ++k) a[k] *= w0;
        unpack8(*(const v4u*)(OG + (size_t)MP * 1024 + off), t);
#pragma unroll
        for (int k = 0; k < 8; ++k) a[k] += w1 * t[k];
        unpack8(*(const v4u*)(OG + (size_t)2 * MP * 1024 + off), t);
        unpack8(*(const v4u*)(GS + off), gsv);
#pragma unroll
        for (int k = 0; k < 8; ++k) a[k] = (a[k] + w2 * t[k]) * gsv[k];
        v4u o; o.x = cvtpk(a[0], a[1]); o.y = cvtpk(a[2], a[3]); o.z = cvtpk(a[4], a[5]); o.w = cvtpk(a[6], a[7]);
        *(v4u*)(AO + off) = o; }
}
__device__ __forceinline__ void p10_final(Frame& F) {
    const float* SSQ2 = (const float*)(F.ws + WS_SSQ2); const float* fn = F.in[I_FN]; float* Y = F.out + O_YP;
    const int gt = F.vcu * (NWAVES * 64) + F.tid, NT = F.G * NWAVES * 64;
    for (int e = gt; e < MP * 256; e += NT) { const int row = e >> 8, c4 = e & 255;
        const f32x4* sp = (const f32x4*)(SSQ2 + (size_t)row * 16); const f32x4 s0 = sp[0], s1 = sp[1], s2 = sp[2], s3 = sp[3];
        const float ss = ((s0[0] + s0[1]) + (s0[2] + s0[3])) + ((s1[0] + s1[1]) + (s1[2] + s1[3])) + ((s2[0] + s2[1]) + (s2[2] + s2[3])) + ((s3[0] + s3[1]) + (s3[2] + s3[3]));
        const float rs = __builtin_amdgcn_rsqf(ss * (1.f / 1024.f) + EPS);
        f32x4* p = (f32x4*)(Y + (size_t)row * 1024) + c4; const f32x4 g4 = ((const f32x4*)fn)[c4]; *p = *p * rs * g4; }
    const float* HS2 = (const float*)(F.ws + WS_HS2);
    for (int m = F.gw; m < MS; m += F.NGW) { const GAS f32x4* xr = (const GAS f32x4*)(HS2 + (size_t)m * DM) + F.lane; const GAS f32x4* gr = (const GAS f32x4*)fn + F.lane;
        f32x4 v[4]; float s = 0.f;
#pragma unroll
        for (int j = 0; j < 4; ++j) { v[j] = xr[64 * j]; s += (v[j].x * v[j].x + v[j].y * v[j].y) + (v[j].z * v[j].z + v[j].w * v[j].w); }
        const float rstd = __builtin_amdgcn_rsqf(wave_sum(s) * (1.f / 1024.f) + EPS);
        f32x4* o = (f32x4*)(F.out + O_YS + (size_t)m * DM) + F.lane;
#pragma unroll
        for (int j = 0; j < 4; ++j) o[64 * j] = v[j] * rstd * gr[64 * j]; }
}
#define PHASES_REST \
      p2_ssd_a(F); p2_sample(F); GRID_BAR(); \
      p3_scan(F); p3_sample(F); GRID_BAR(); \
      p4_ssd_b(F); p4_sample(F); GRID_BAR(); \
      { pg8::Gemm g{(const pg8::bf16_t*)(F.ws + WS_YG), (const pg8::bf16_t*)(F.ws + WS_WOUT), MP, DM, SI}; pg8::StaticOrder S; S.init(MP, DM, F.G, (int)blockIdx.x); \
               pg8::EpiG2 E{F.in[I_XP], F.out + O_YP, (pg8::bf16_t*)(F.ws + WS_H1B), (const float*)(F.ws + WS_SSQG), (float*)(F.ws + WS_SSQ1)}; \
               pg8::gemm_phase<pg8::EpiG2, pg8::StaticOrder, true, true>(F.lds, g, S, E); } \
             __syncthreads(); p5_sample_attn(F); GRID_BAR(); \
      { pg8::Gemm g{(const pg8::bf16_t*)(F.ws + WS_H1B), (const pg8::bf16_t*)(F.ws + WS_WKVQ), MP, NKVQ, DM}; pg8::StaticOrder S; S.init(MP, NKVQ, F.G, (int)blockIdx.x); \
               pg8::EpiG3 E{(const float*)(F.ws + WS_SSQ1), (pg8::bf16_t*)(F.ws + WS_KB), (pg8::bf16_t*)(F.ws + WS_VB), (pg8::bf16_t*)(F.ws + WS_QB), (pg8::bf16_t*)(F.ws + WS_GS), F.out + O_KVP}; \
               pg8::gemm_phase<pg8::EpiG3, pg8::StaticOrder, true, true>(F.lds, g, S, E); } \
             p6_sample(F); GRID_BAR(); \
      p7_attention(F); GRID_BAR(); \
      p8_combine(F); GRID_BAR(); \
      { pg8::Gemm g{(const pg8::bf16_t*)(F.ws + WS_AO), (const pg8::bf16_t*)(F.ws + WS_WBOUT), MP, DM, DM}; pg8::StaticOrder S; S.init(MP, DM, F.G, (int)blockIdx.x); \
               pg8::EpiG4 E{F.out + O_YP, (float*)(F.ws + WS_SSQ2)}; \
               pg8::gemm_phase<pg8::EpiG4, pg8::StaticOrder, true, true>(F.lds, g, S, E); } \
             GRID_BAR(); \
      p10_final(F);
__global__ void __launch_bounds__(NWAVES * 64, 2) yoco_fwd(Args args) {
    extern __shared__ __attribute__((aligned(16))) unsigned char lds[];
    Frame F;
    F.lds = (LAS unsigned char*)lds; F.MISC = (volatile LAS unsigned*)(F.lds + MISC_OFF);
    F.tid = threadIdx.x; F.lane = F.tid & 63; F.wave = __builtin_amdgcn_readfirstlane(F.tid >> 6);
    F.G = gridDim.x; { const int bx = blockIdx.x; F.vcu = (F.G % 8 == 0) ? (bx % 8) * (F.G / 8) + bx / 8 : bx; }
    F.gw = F.vcu * NWAVES + F.wave; F.NGW = F.G * NWAVES;
    F.in = args.in; F.out = args.out; F.ws = args.ws; F.ctl = (gu32*)(args.ws + WS_CTL);
    for (int u = F.tid; u < (LDS_BYTES - LDSCTL_OFF) / 4; u += NWAVES * 64) ((LAS unsigned*)(F.lds + LDSCTL_OFF))[u] = 0u;
    __syncthreads();
    XcdBarrier bar = xcd_barrier_post((unsigned*)(F.ctl + CW_BAR), F.MISC + 8);
    if (args.never) cg::this_grid().sync();
#define GRID_BAR() xcd_barrier(bar)

    p0_prologue(F);
    GRID_BAR();
    {
        pg8::Gemm g{(const pg8::bf16_t*)(F.ws + WS_XN), (const pg8::bf16_t*)(F.ws + WS_WIN), MP, 5120, DM}; pg8::StaticOrder S; S.init(MP, 5120, F.G, (int)blockIdx.x);
        pg8::EpiG1 E{(pg8::bf16_t*)(F.ws + WS_Z), (pg8::bf16_t*)(F.ws + WS_XBC), F.out + O_CONVP};
        pg8::gemm_phase<pg8::EpiG1, pg8::StaticOrder, true, true>(F.lds, g, S, E);
        p1_small(F);
    }
    GRID_BAR();
    PHASES_REST
}

extern "C" void kernel_launch(void* const* d_in, const int* in_sizes, int n_in, void* d_out, int out_size, void* d_ws, size_t ws_size, hipStream_t stream) {
    static int grid = 0;
    if (grid == 0) {
        if (n_in != N_IN || (size_t)out_size != O_END || ws_size < WS_END) { fprintf(stderr, "kernel_launch: unexpected shapes: n_in %d out %d ws %zu\n", n_in, out_size, ws_size); grid = -1; return; }
        int dev = 0, cus = 0, per_cu = 0;
        if (hipGetDevice(&dev) != hipSuccess || hipDeviceGetAttribute(&cus, hipDeviceAttributeMultiprocessorCount, dev) != hipSuccess) { grid = -1; return; }
        if (hipFuncSetAttribute((const void*)yoco_fwd, hipFuncAttributeMaxDynamicSharedMemorySize, LDS_BYTES) != hipSuccess) { fprintf(stderr, "kernel_launch: hipFuncSetAttribute failed\n"); grid = -1; return; }
        if (hipOccupancyMaxActiveBlocksPerMultiprocessor(&per_cu, (const void*)yoco_fwd, NWAVES * 64, LDS_BYTES) != hipSuccess || per_cu < 1) { fprintf(stderr, "kernel_launch: occupancy query says %d\n", per_cu); (void)hipGetLastError(); grid = -1; return; }
        grid = cus;
    }
    if (grid < 0) return;
    if (hipMemsetAsync((char*)d_ws + WS_CTL, 0, CTL_ZERO_BYTES, stream) != hipSuccess) { fprintf(stderr, "kernel_launch: memset failed\n"); return; }
    Args a{};
    for (int i = 0; i < N_IN; ++i) a.in[i] = (const float*)d_in[i];
    a.out = (float*)d_out; a.ws = (unsigned char*)d_ws; a.never = 0; a.pad = 0;
    void* kargs[] = {&a};
    hipError_t e = hipLaunchCooperativeKernel((const void*)yoco_fwd, dim3(grid), dim3(NWAVES * 64), kargs, LDS_BYTES, stream);
    if (e != hipSuccess) fprintf(stderr, "kernel_launch: cooperative launch failed: %s (grid %d)\n", hipGetErrorString(e), grid);
}
```

```cpp
#include <hip/hip_runtime.h>
#include <hip/hip_cooperative_groups.h>
#include <cstdio>
#include <cstdint>
namespace cg = cooperative_groups;

namespace pg8 {
#define PG8_LAS __attribute__((address_space(3)))
typedef unsigned short bf16_t;
typedef short bf16x8 __attribute__((ext_vector_type(8)));
typedef float f32x4 __attribute__((ext_vector_type(4)));
typedef unsigned u32x4 __attribute__((ext_vector_type(4)));
constexpr int BM = 256, BK = 64, HALF = 128, HTB = HALF * BK * 2  , STAGE_BYTES = 8 * HTB, NXCD = 8, WGM = 8;

__host__ __device__ __forceinline__ int lds_byte(int r, int c) { const int st = (r >> 4) * 2 + (c >> 5), rr = r & 15, cc = c & 31, ob = rr * 64 + cc * 2; return st * 1024 + (ob ^ (((ob >> 9) & 1) << 5)); }
__host__ __device__ __forceinline__ void stage_rc(int b, int& R, int& C) { const int st = b / 1024, sb = b % 1024, swz = sb ^ (((sb >> 9) & 1) << 5); R = (st >> 1) * 16 + swz / 64; C = (st & 1) * 32 + (swz % 64) / 2; }
__host__ __device__ __forceinline__ int perm32(int rho) { const int n = rho >> 4, i = rho & 15; return 8 * (i >> 2) + 4 * n + (i & 3); }

struct Unit { int pm, pn; };
struct Gemm { const bf16_t* A; const bf16_t* Bt; int M, N, K; };

struct StaticOrder {
    int nM, nN, nwg, G, c; int rep = 1;
    __host__ __device__ void init(int M, int N, int G_, int c_) { nM = M / BM; nN = N / BM; nwg = nM * nN; G = G_; c = c_; }
    __host__ __device__ bool next(int i, Unit& u) const {
        long L = (long)i * G + c; if (L >= (long)nwg * rep) return false; L %= nwg;
        int wgid = (int)L; { const int q = nwg / NXCD, r = nwg % NXCD, xcd = wgid % NXCD, off = wgid / NXCD; wgid = (xcd < r ? xcd * (q + 1) : r * (q + 1) + (xcd - r) * q) + off; }
        const int nig = WGM * nN, gid = wgid / nig, fm = gid * WGM, gsz = (nM - fm) < WGM ? (nM - fm) : WGM;
        u.pm = fm + ((wgid % nig) % gsz); u.pn = (wgid % nig) / gsz; return true;
    }
    __device__ __forceinline__ void a_ready(const Unit&) const {}
    __device__ __forceinline__ void done(const Unit&) const {}
};
typedef float f32x2 __attribute__((ext_vector_type(2)));
typedef __bf16 bf16x2v __attribute__((ext_vector_type(2)));
__device__ __forceinline__ unsigned cvt_pk_bf16(float lo, float hi) { f32x2 v = {lo, hi}; bf16x2v b = __builtin_convertvector(v, bf16x2v); return __builtin_bit_cast(unsigned, b); }
template <class Epi, class Sched, bool ALIGN_EPI = false, bool SP2 = false>
__device__ __forceinline__ void gemm_phase(PG8_LAS unsigned char* lds, const Gemm g, const Sched& S, const Epi& E) {
    int tid_ = threadIdx.x; asm volatile("" : "+v"(tid_));
    const int tid = tid_, wid = __builtin_amdgcn_readfirstlane(tid >> 6), lane = tid & 63, wr = wid >> 2, wc = wid & 3, fr = lane & 15, fq = lane >> 4;
    const int K = g.K, nt = K / BK;
    unsigned voffA[2], voffB[2];
#pragma unroll
    for (int i = 0; i < 2; ++i) { int R, C; stage_rc(tid * 16 + i * 8192, R, C); const int Rb = Epi::PERM ? ((R & ~31) + perm32(R & 31)) : R;
        voffA[i] = (unsigned)(R * K + C) * 2u; voffB[i] = (unsigned)(Rb * K + C) * 2u; }
    const size_t kstep = (size_t)(BK * 2);
    const size_t hstep = (size_t)HALF * K * 2;
    const size_t tstep = 2 * hstep;
    const unsigned ldsw = (unsigned)wid * 1024u;
    const int aoff = lds_byte(wr * 64 + fr, fq * 8), boff = lds_byte(wc * 32 + fr, fq * 8);
#define PG8_SA(b, h) (((b) * 2 + (h)) * HTB)
#define PG8_SB(b, h) ((4 + (b) * 2 + (h)) * HTB)
#define PG8_STAGE(bufoff, gbase, voff) do { _Pragma("unroll") for (int _i = 0; _i < 2; ++_i) \
        __builtin_amdgcn_global_load_lds((const unsigned*)((const char*)(gbase) + (voff)[_i]), (PG8_LAS unsigned*)(lds + (bufoff) + ldsw + _i * 8192), 16, 0, 0); } while (0)
#define PG8_LDA(dst, b, h) do { _Pragma("unroll") for (int m = 0; m < 4; ++m) _Pragma("unroll") for (int k = 0; k < 2; ++k) dst[m][k] = *(const PG8_LAS bf16x8*)(lds + PG8_SA(b, h) + aoff + m * 2048 + k * 1024); } while (0)
#define PG8_LDB(dst, b, h) do { _Pragma("unroll") for (int n = 0; n < 2; ++n) _Pragma("unroll") for (int k = 0; k < 2; ++k) dst[n][k] = *(const PG8_LAS bf16x8*)(lds + PG8_SB(b, h) + boff + n * 2048 + k * 1024); } while (0)
#define PG8_MMA(ai, bj, At, Bt) do { __builtin_amdgcn_s_setprio(1); _Pragma("unroll") for (int m = 0; m < 4; ++m) _Pragma("unroll") for (int n = 0; n < 2; ++n) _Pragma("unroll") for (int k = 0; k < 2; ++k) \
        acc[ai][bj][m][n] = __builtin_amdgcn_mfma_f32_16x16x32_bf16(Bt[n][k], At[m][k], acc[ai][bj][m][n], 0, 0, 0); __builtin_amdgcn_s_setprio(0); } while (0)
#define PG8_WAIT_V(n) asm volatile("s_waitcnt vmcnt(" #n ")" ::: "memory")
#define PG8_WAIT_L(n) asm volatile("s_waitcnt lgkmcnt(" #n ")" ::: "memory")
#define PG8_BAR __builtin_amdgcn_s_barrier()
#define PG8_SCHED __builtin_amdgcn_sched_barrier(0)
    Unit cur, nxt; int ui = 0;
    if (!S.next(0, cur)) return;
    f32x4 acc[2][2][4][2];
#pragma unroll
    for (int a = 0; a < 2; ++a)
#pragma unroll
        for (int b = 0; b < 2; ++b)
#pragma unroll
            for (int m = 0; m < 4; ++m)
#pragma unroll
                for (int n = 0; n < 2; ++n) acc[a][b][m][n] = (f32x4){0.f, 0.f, 0.f, 0.f};
    bf16x8 At[4][2], B0[2][2], B1[2][2];
    const char* cA = (const char*)g.A + (size_t)cur.pm * tstep; const char* cB = (const char*)g.Bt + (size_t)cur.pn * tstep;
    S.a_ready(cur);
    if constexpr (SP2) {
        PG8_STAGE(PG8_SB(0, 0), cB, voffB); PG8_STAGE(PG8_SB(0, 1), cB + hstep, voffB); PG8_STAGE(PG8_SA(0, 0), cA, voffA); PG8_STAGE(PG8_SA(0, 1), cA + hstep, voffA);
        if (wr == 1) PG8_BAR;
        PG8_WAIT_V(2); PG8_BAR;
        PG8_STAGE(PG8_SB(1, 0), cB + kstep, voffB); PG8_STAGE(PG8_SA(1, 0), cA + kstep, voffA); PG8_STAGE(PG8_SB(1, 1), cB + hstep + kstep, voffB);
        PG8_WAIT_V(6); PG8_BAR;
    } else {
        PG8_STAGE(PG8_SB(0, 0), cB, voffB); PG8_STAGE(PG8_SA(0, 0), cA, voffA); PG8_STAGE(PG8_SB(0, 1), cB + hstep, voffB); PG8_STAGE(PG8_SA(0, 1), cA + hstep, voffA);
        if (wr == 1) PG8_BAR;
        PG8_WAIT_V(4); PG8_BAR;
        PG8_STAGE(PG8_SB(1, 0), cB + kstep, voffB); PG8_STAGE(PG8_SA(1, 0), cA + kstep, voffA); PG8_STAGE(PG8_SB(1, 1), cB + hstep + kstep, voffB);
        PG8_WAIT_V(6); PG8_BAR;
    }
    for (;;) {
        const bool has_next = S.next(ui + 1, nxt);
        const char* nA = has_next ? (const char*)g.A + (size_t)nxt.pm * tstep : cA; const char* nB = has_next ? (const char*)g.Bt + (size_t)nxt.pn * tstep : cB;
        for (int t = 0; t < nt; t += 2) {
            const bool last = (t == nt - 2);
            const char* a1 = cA + (size_t)(t + 1) * kstep;
            const char* a2 = last ? nA : cA + (size_t)(t + 2) * kstep; const char* b2 = last ? nB : cB + (size_t)(t + 2) * kstep;
            const char* a3 = a2 + kstep; const char* b3 = b2 + kstep;
            if (last && has_next) S.a_ready(nxt);
            if constexpr (SP2) {
            PG8_LDB(B0, 0, 0); PG8_LDB(B1, 0, 1); PG8_SCHED; PG8_LDA(At, 0, 0); PG8_STAGE(PG8_SA(1, 1), a1 + hstep, voffA);
            PG8_WAIT_V(8); PG8_WAIT_L(0); PG8_BAR; PG8_MMA(0, 0, At, B0); PG8_MMA(0, 1, At, B1); PG8_BAR; PG8_SCHED;
            PG8_LDA(At, 0, 1); PG8_STAGE(PG8_SB(0, 0), b2, voffB); PG8_STAGE(PG8_SB(0, 1), b2 + hstep, voffB); PG8_STAGE(PG8_SA(0, 0), a2, voffA);
            PG8_WAIT_V(8); PG8_WAIT_L(0); PG8_BAR; PG8_MMA(1, 0, At, B0); PG8_MMA(1, 1, At, B1); PG8_BAR; PG8_SCHED;
            PG8_LDB(B0, 1, 0); PG8_LDB(B1, 1, 1); PG8_SCHED; PG8_LDA(At, 1, 0); PG8_STAGE(PG8_SA(0, 1), a2 + hstep, voffA);
            PG8_WAIT_V(8); PG8_WAIT_L(0); PG8_BAR; PG8_MMA(0, 0, At, B0); PG8_MMA(0, 1, At, B1); PG8_BAR; PG8_SCHED;
            PG8_LDA(At, 1, 1); PG8_STAGE(PG8_SB(1, 0), b3, voffB); PG8_STAGE(PG8_SB(1, 1), b3 + hstep, voffB); PG8_STAGE(PG8_SA(1, 0), a3, voffA);
            PG8_WAIT_V(8); PG8_WAIT_L(0); PG8_BAR; PG8_MMA(1, 0, At, B0); PG8_MMA(1, 1, At, B1); PG8_BAR; PG8_SCHED;
            } else {
            PG8_LDB(B0, 0, 0); PG8_SCHED; PG8_LDA(At, 0, 0); PG8_STAGE(PG8_SA(1, 1), a1 + hstep, voffA);
            PG8_WAIT_L(8); PG8_BAR; PG8_WAIT_L(0); PG8_MMA(0, 0, At, B0); PG8_BAR; PG8_SCHED;
            PG8_LDB(B1, 0, 1); PG8_STAGE(PG8_SB(0, 0), b2, voffB);
            PG8_BAR; PG8_WAIT_L(0); PG8_MMA(0, 1, At, B1); PG8_BAR;
            PG8_LDA(At, 0, 1); PG8_STAGE(PG8_SA(0, 0), a2, voffA);
            PG8_BAR; PG8_WAIT_L(0); PG8_MMA(1, 0, At, B0); PG8_BAR; PG8_SCHED;
            PG8_STAGE(PG8_SB(0, 1), b2 + hstep, voffB);
            PG8_WAIT_V(6); PG8_BAR; PG8_MMA(1, 1, At, B1); PG8_BAR;
            PG8_LDB(B0, 1, 0); PG8_SCHED; PG8_LDA(At, 1, 0); PG8_STAGE(PG8_SA(0, 1), a2 + hstep, voffA);
            PG8_WAIT_L(8); PG8_BAR; PG8_WAIT_L(0); PG8_MMA(0, 0, At, B0); PG8_BAR; PG8_SCHED;
            PG8_LDB(B1, 1, 1); PG8_STAGE(PG8_SB(1, 0), b3, voffB);
            PG8_BAR; PG8_WAIT_L(0); PG8_MMA(0, 1, At, B1); PG8_BAR;
            PG8_LDA(At, 1, 1); PG8_STAGE(PG8_SA(1, 0), a3, voffA);
            PG8_BAR; PG8_WAIT_L(0); PG8_MMA(1, 0, At, B0); PG8_BAR; PG8_SCHED;
            PG8_STAGE(PG8_SB(1, 1), b3 + hstep, voffB);
            PG8_WAIT_V(6); PG8_BAR; PG8_MMA(1, 1, At, B1); PG8_BAR;
            }
        }
        if constexpr (ALIGN_EPI) { if (wr == 0) PG8_BAR; }
        if constexpr (!Epi::AFTER_DRAIN) { E(acc, cur, wr, wc, fr, fq); S.done(cur); }
        if (!has_next) break;
#pragma unroll
        for (int a = 0; a < 2; ++a)
#pragma unroll
            for (int b = 0; b < 2; ++b)
#pragma unroll
                for (int m = 0; m < 4; ++m)
#pragma unroll
                    for (int n = 0; n < 2; ++n) acc[a][b][m][n] = (f32x4){0.f, 0.f, 0.f, 0.f};
        cur = nxt; cA = nA; cB = nB; ++ui;
        if constexpr (ALIGN_EPI) { if (wr == 1) PG8_BAR; }
    }
    PG8_WAIT_V(0);
    if constexpr (!ALIGN_EPI) { if (wr == 0) PG8_BAR; }
    PG8_BAR;
    if constexpr (Epi::AFTER_DRAIN) { E.fused(acc, cur, wr, wc, fr, fq, lds, wid, lane); S.done(cur); }
#undef PG8_SA
#undef PG8_SB
#undef PG8_STAGE
#undef PG8_LDA
#undef PG8_LDB
#undef PG8_MMA
#undef PG8_WAIT_V
#undef PG8_WAIT_L
#undef PG8_BAR
#undef PG8_SCHED
}
struct EpiG1 {
    static constexpr bool PERM = true, AFTER_DRAIN = false;
    bf16_t* Z; bf16_t* XBC; float* convp;
    __device__ __forceinline__ void operator()(const f32x4 (&acc)[2][2][4][2], const Unit& u, int wr, int wc, int fr, int fq) const {
        const int row0 = u.pm * BM + wr * 64 + fr; int colt = u.pn * BM; bf16_t* base; int ldc; bool isx;
        if (colt < 2048) { base = Z; ldc = 2048; isx = false; } else { base = XBC; ldc = 3072; colt -= 2048; isx = true; }
        const int col0 = colt + wc * 32 + 8 * fq;
#pragma unroll
        for (int ai = 0; ai < 2; ++ai)
#pragma unroll
            for (int m = 0; m < 4; ++m) { const int row = row0 + ai * HALF + m * 16; bf16_t* rowp = base + (size_t)row * ldc + col0;
                const bool tail = isx && ((row & 4095) >= 4093);
#pragma unroll
                for (int bj = 0; bj < 2; ++bj) { const f32x4 v0 = acc[ai][bj][m][0], v1 = acc[ai][bj][m][1];
                    u32x4 w; w.x = cvt_pk_bf16(v0[0], v0[1]); w.y = cvt_pk_bf16(v0[2], v0[3]); w.z = cvt_pk_bf16(v1[0], v1[1]); w.w = cvt_pk_bf16(v1[2], v1[3]);
                    *(u32x4*)(rowp + bj * HALF) = w;
                    if (tail) { float* cp = convp + (size_t)((row >> 12) * 3 + ((row & 4095) - 4093)) * 3072 + col0 + bj * HALF; *(f32x4*)cp = v0; *(f32x4*)(cp + 4) = v1; } } }
    }
};
struct EpiG2 {
    static constexpr bool PERM = false, AFTER_DRAIN = false;
    const float* X; float* H1; bf16_t* H1B; const float* ssqg; float* ssq1;
    __device__ __forceinline__ void operator()(const f32x4 (&acc)[2][2][4][2], const Unit& u, int wr, int wc, int fr, int fq) const {
        const int row0 = u.pm * BM + wr * 64 + fr, col0 = u.pn * BM + wc * 32 + 4 * fq;
#pragma unroll
        for (int ai = 0; ai < 2; ++ai)
#pragma unroll
            for (int m = 0; m < 4; ++m) { const int row = row0 + ai * HALF + m * 16; const size_t off = (size_t)row * 1024 + col0;
                const f32x4 sg = *(const f32x4*)(ssqg + (size_t)row * 4);
                const float rs = __builtin_amdgcn_rsqf(((sg[0] + sg[1]) + (sg[2] + sg[3])) * (1.0f / 2048.0f) + 1e-5f);
                float q = 0.f;
#pragma unroll
                for (int bj = 0; bj < 2; ++bj)
#pragma unroll
                    for (int n = 0; n < 2; ++n) { const f32x4 xv = *(const f32x4*)(X + off + bj * HALF + n * 16); const f32x4 h = xv + acc[ai][bj][m][n] * rs;
                        *(f32x4*)(H1 + off + bj * HALF + n * 16) = h; q += (h[0] * h[0] + h[1] * h[1]) + (h[2] * h[2] + h[3] * h[3]);
                        typedef unsigned u32x2v __attribute__((ext_vector_type(2))); u32x2v w; w.x = cvt_pk_bf16(h[0], h[1]); w.y = cvt_pk_bf16(h[2], h[3]);
                        *(u32x2v*)(H1B + off + bj * HALF + n * 16) = w; }
                q += __shfl_xor(q, 16); q += __shfl_xor(q, 32);
                if (fq == 0) ssq1[(size_t)row * 16 + u.pn * 4 + wc] = q; }
    }
};
struct EpiG3 {
    static constexpr bool PERM = true, AFTER_DRAIN = false;
    const float* ssq1; bf16_t* KB; bf16_t* VB; bf16_t* QB; bf16_t* GS; float* kvp;
    __device__ __forceinline__ void operator()(const f32x4 (&acc)[2][2][4][2], const Unit& u, int wr, int wc, int fr, int fq) const {
        const int row0 = u.pm * BM + wr * 64 + fr; const int colt = u.pn * BM + wc * 32 + 8 * fq;
#pragma unroll
        for (int ai = 0; ai < 2; ++ai)
#pragma unroll
            for (int m = 0; m < 4; ++m) { const int row = row0 + ai * HALF + m * 16; const int b = row >> 12, pos = row & 4095;
                const f32x4* sp = (const f32x4*)(ssq1 + (size_t)row * 16); const f32x4 s0 = sp[0], s1 = sp[1], s2 = sp[2], s3 = sp[3];
                const float ss = ((s0[0] + s0[1]) + (s0[2] + s0[3])) + ((s1[0] + s1[1]) + (s1[2] + s1[3])) + ((s2[0] + s2[1]) + (s2[2] + s2[3])) + ((s3[0] + s3[1]) + (s3[2] + s3[3]));
                const float rs = __builtin_amdgcn_rsqf(ss * (1.0f / 1024.0f) + 1e-5f);
#pragma unroll
                for (int bj = 0; bj < 2; ++bj) { const int col = colt + bj * HALF; f32x4 v0 = acc[ai][bj][m][0] * rs, v1 = acc[ai][bj][m][1] * rs;
                    bf16_t* dst;
                    if (col < 2048) { const int kv = col >> 10, h = (col & 1023) >> 7, d = col & 127;
                        dst = (kv ? VB : KB) + ((size_t)(b * 8 + h) * 4096 + pos) * 128 + d;
                        if (pos >= 2048) { float* kp = kvp + ((size_t)(b * 2048 + (pos - 2048)) * 2 + kv) * 1024 + h * 128 + d; *(f32x4*)kp = v0; *(f32x4*)(kp + 4) = v1; }
                    } else if (col < 5120) { const int qc = col - 2048, g = qc >> 10, h = (qc & 1023) >> 7, d = qc & 127;
                        dst = QB + ((size_t)((b * 3 + g) * 8 + h) * 4096 + pos) * 128 + d;
                        const float sc = 0.08838834764831845f * 1.4426950408889634f; v0 = v0 * sc; v1 = v1 * sc;
                    } else { dst = GS + (size_t)row * 1024 + (col - 5120);
#pragma unroll
                        for (int e = 0; e < 4; ++e) { v0[e] = v0[e] * __builtin_amdgcn_rcpf(1.0f + __builtin_amdgcn_exp2f(-1.4426950408889634f * v0[e])); v1[e] = v1[e] * __builtin_amdgcn_rcpf(1.0f + __builtin_amdgcn_exp2f(-1.4426950408889634f * v1[e])); } }
                    u32x4 w; w.x = cvt_pk_bf16(v0[0], v0[1]); w.y = cvt_pk_bf16(v0[2], v0[3]); w.z = cvt_pk_bf16(v1[0], v1[1]); w.w = cvt_pk_bf16(v1[2], v1[3]);
                    *(u32x4*)dst = w; } }
    }
};
struct EpiG4 {
    static constexpr bool PERM = false, AFTER_DRAIN = false;
    float* H; float* ssq2;
    __device__ __forceinline__ void operator()(const f32x4 (&acc)[2][2][4][2], const Unit& u, int wr, int wc, int fr, int fq) const {
        const int row0 = u.pm * BM + wr * 64 + fr, col0 = u.pn * BM + wc * 32 + 4 * fq;
#pragma unroll
        for (int ai = 0; ai < 2; ++ai)
#pragma unroll
            for (int m = 0; m < 4; ++m) { const int row = row0 + ai * HALF + m * 16; const size_t off = (size_t)row * 1024 + col0; float q = 0.f;
#pragma unroll
                for (int bj = 0; bj < 2; ++bj)
#pragma unroll
                    for (int n = 0; n < 2; ++n) { float* p = H + off + bj * HALF + n * 16; const f32x4 h = *(const f32x4*)p + acc[ai][bj][m][n]; *(f32x4*)p = h;
                        q += (h[0] * h[0] + h[1] * h[1]) + (h[2] * h[2] + h[3] * h[3]); }
                q += __shfl_xor(q, 16); q += __shfl_xor(q, 32);
                if (fq == 0) ssq2[(size_t)row * 16 + u.pn * 4 + wc] = q; }
    }
};
}
#ifndef REP_A
#define REP_A 1
#endif
#ifndef REP_B
#define REP_B 1
#endif
#ifndef REP_C
#define REP_C 1
#endif
#ifndef REP_D
#define REP_D 1
#endif
#ifndef REP_E
#define REP_E 1
#endif
#ifndef REP_F
#define REP_F 1
#endif
constexpr int NWAVES = 8;
constexpr int DM = 1024, NBATCH = 4, SEQ = 4096, MP = NBATCH * SEQ  , SB = 32, ST = 4, MS = SB * ST  ;
constexpr int SI = 2048, CD = 3072, NH = 32, HP = 64, NS = 128, NIN = 5152, NCH = SEQ / 128  ;
constexpr int NKVQ = 6144;
constexpr float EPS = 1e-5f;
constexpr float LOG2E = 1.4426950408889634f, LN2 = 0.6931471805599453f;
enum { I_XP = 0, I_XS, I_SSM, I_CONV, I_CACHE, I_ANORM, I_AWIN, I_ACONVW, I_ACONVB, I_ADTB, I_AALOG, I_AD, I_AGN, I_AWOUT, I_RELB, I_KVN, I_WKV, I_BN, I_BWIN, I_BWOUT, I_FN, N_IN };
constexpr size_t O_YP = 0, O_YS = 16777216, O_SSMP = O_YS + 131072, O_SSMS = O_SSMP + 1048576, O_CONVP = O_SSMS + 8388608, O_CONVS = O_CONVP + 36864, O_KVP = O_CONVS + 294912, O_KVS = O_KVP + 16777216, O_END = O_KVS + 262144;
constexpr size_t MiB = 1u << 20;
constexpr size_t WS_CTL = 0, CTL_ZERO_BYTES = 1 * MiB;
constexpr size_t WS_WIN = 2 * MiB, WS_WOUT = 13 * MiB, WS_WKVQ = 17 * MiB, WS_WBOUT = 29 * MiB;
constexpr size_t WS_XN = 32 * MiB;
constexpr size_t WS_Z = 65 * MiB;
constexpr size_t WS_XBC = 129 * MiB;
constexpr size_t WS_DT = 225 * MiB;
constexpr size_t WS_ACT = 228 * MiB;
constexpr size_t WS_DTV = 324 * MiB, WS_ACS = 326 * MiB;
constexpr size_t WS_CS = 328 * MiB;
constexpr size_t WS_SIN = WS_CS;
constexpr size_t WS_YG = 520 * MiB;
constexpr size_t WS_SSQG = 584 * MiB, WS_SSQ1 = 585 * MiB, WS_SSQ2 = 586 * MiB;
constexpr size_t WS_H1B = 587 * MiB;
constexpr size_t WS_KB = 619 * MiB, WS_VB = 651 * MiB, WS_QB = 683 * MiB, WS_GS = 779 * MiB;
constexpr size_t WS_OG = 811 * MiB;
constexpr size_t WS_LSE = 907 * MiB;
constexpr size_t WS_AO = 909 * MiB;
constexpr size_t WS_US = 944 * MiB;
constexpr size_t WS_YGS = 948 * MiB;
constexpr size_t WS_SSQGS = 949 * MiB;
constexpr size_t WS_HS1 = 950 * MiB;
constexpr size_t WS_HS1B = 951 * MiB;
constexpr size_t WS_KVQS = 952 * MiB;
constexpr size_t WS_AOS = 956 * MiB;
constexpr size_t WS_HS2 = 957 * MiB;
constexpr size_t WS_END = 960 * MiB;
constexpr int CW_BAR = 4096;
constexpr int RING_BYTES = 131072;
constexpr int LDS_X_OFF = RING_BYTES, LDS_X_BYTES = 28672;
constexpr int LDSCTL_OFF = LDS_X_OFF + LDS_X_BYTES, MISC_OFF = LDSCTL_OFF + 320;
constexpr int LDS_BYTES = 163840;
static_assert(MISC_OFF + 128 <= LDS_BYTES, "LDS map");
#define GAS __attribute__((address_space(1)))
#define LAS __attribute__((address_space(3)))
typedef unsigned short bf16;
typedef unsigned v4u __attribute__((ext_vector_type(4)));
typedef float f32x4 __attribute__((ext_vector_type(4)));
typedef short bf16x8 __attribute__((ext_vector_type(8)));
typedef GAS unsigned gu32;
typedef GAS unsigned long long gu64;
#define RLX_AGENT __ATOMIC_RELAXED, __HIP_MEMORY_SCOPE_AGENT
#define LDS_WAIT() asm volatile("s_waitcnt lgkmcnt(0)" ::: "memory")
#define VM_WAIT() asm volatile("s_waitcnt vmcnt(0)" ::: "memory")
__device__ __forceinline__ unsigned long long rt() { return __builtin_amdgcn_s_memrealtime(); }
__device__ __forceinline__ unsigned f2bf(float f) { unsigned u = __builtin_bit_cast(unsigned, f); return (u + 0x7fffu + ((u >> 16) & 1u)) >> 16; }
__device__ __forceinline__ unsigned pk2(float lo, float hi) { return f2bf(lo) | (f2bf(hi) << 16); }
__device__ __forceinline__ float wave_sum(float v) {
#pragma unroll
    for (int o = 1; o < 64; o <<= 1) v += __shfl_xor(v, o);
    return v;
}
#define XB_TMO      128
#define XB_XCNT(j)  (256  + 64 * (j))
#define XB_XSUB(j)  (1280 + 64 * (j))
#define XB_XGEN(j)  (2304 + 64 * (j))
#define XB_TOP      3328
#define XB_TOPGEN   3392
#define XCD_BAR_WORDS 3456
#define XB_SPIN_CAP (1u << 18)

__device__ __forceinline__ unsigned xb_ld(unsigned* p)              { return __hip_atomic_load(p, __ATOMIC_RELAXED, __HIP_MEMORY_SCOPE_AGENT); }
__device__ __forceinline__ unsigned xb_add(unsigned* p, unsigned v) { return __hip_atomic_fetch_add(p, v, __ATOMIC_RELAXED, __HIP_MEMORY_SCOPE_AGENT); }
__device__ __forceinline__ unsigned xb_xcc_id() { return (unsigned)__builtin_amdgcn_s_getreg((3 << 11) | 20) & 0xFu; }
#define XB_SPIN(cond, bar) do { unsigned _sp = 0; while (cond) { __builtin_amdgcn_s_sleep(1); \
    if ((++_sp & 255u) == 0u) { if (xb_ld(&(bar)[XB_TMO])) break; if (_sp > XB_SPIN_CAP) { atomicAdd(&(bar)[XB_TMO], 1u); break; } } } } while (0)

struct XcdBarrier {
    unsigned* bar; unsigned x;
    volatile LAS unsigned* st;
};

__device__ __forceinline__ XcdBarrier xcd_barrier_post(unsigned* bar, volatile LAS unsigned* st) {
    XcdBarrier b; b.bar = bar; b.x = xb_xcc_id(); b.st = st;
    if (threadIdx.x == 0) (void)xb_add(&bar[XB_XCNT(b.x)], 1u);
    return b;
}
__device__ __forceinline__ void xcd_barrier_complete(unsigned* bar, unsigned x, unsigned& nloc, unsigned& nx) {
    const unsigned G = gridDim.x * gridDim.y * gridDim.z;
    unsigned sum, cnt, mine, sp = 0u;
    for (;;) {
        sum = 0u; cnt = 0u; mine = 0u;
#pragma unroll
        for (unsigned j = 0; j < 16; ++j) { const unsigned c = xb_ld(&bar[XB_XCNT(j)]); sum += c; cnt += (c > 0u) ? 1u : 0u; mine = (j == x) ? c : mine; }
        if (sum == G) break;
        __builtin_amdgcn_s_sleep(1);
        if ((++sp & 255u) == 0u) { if (xb_ld(&bar[XB_TMO])) break; if (sp > XB_SPIN_CAP) { atomicAdd(&bar[XB_TMO], 1u); break; } }
    }
    nloc = mine > 0u ? mine : 1u; nx = cnt > 0u ? cnt : 1u;
}

__device__ __forceinline__ void xcd_barrier(const XcdBarrier& b) {
    asm volatile("s_waitcnt vmcnt(0)" ::: "memory");
    __syncthreads();
    if (threadIdx.x == 0) {
        unsigned* bar = b.bar;
        __builtin_amdgcn_s_waitcnt(0);
        unsigned nloc = b.st[0], nx = b.st[1];
        if (nloc == 0u) { xcd_barrier_complete(bar, b.x, nloc, nx); b.st[0] = nloc; b.st[1] = nx; }
        const unsigned old = xb_add(&bar[XB_XSUB(b.x)], 1u);
        const unsigned gen = old / nloc;
        if (old + 1u == (gen + 1u) * nloc) {
            __builtin_amdgcn_fence(__ATOMIC_RELEASE, "agent");
            asm volatile("s_waitcnt vmcnt(0)" ::: "memory");
            const unsigned og = xb_add(&bar[XB_TOP], 1u);
            const unsigned tg = og / nx;
            if (og + 1u == (tg + 1u) * nx) xb_add(&bar[XB_TOPGEN], 1u);
            else XB_SPIN(xb_ld(&bar[XB_TOPGEN]) == tg, bar);
            __builtin_amdgcn_fence(__ATOMIC_ACQUIRE, "agent");
            xb_add(&bar[XB_XGEN(b.x)], 1u);
            asm volatile("s_waitcnt vmcnt(0)" ::: "memory");
        } else {
            XB_SPIN(xb_ld(&bar[XB_XGEN(b.x)]) == gen, bar);
            __builtin_amdgcn_fence(__ATOMIC_ACQUIRE, "agent");
            asm volatile("s_waitcnt vmcnt(0)" ::: "memory");
        }
    }
    __syncthreads();
}
typedef float f32x2 __attribute__((ext_vector_type(2)));
typedef short s16x4 __attribute__((ext_vector_type(4)));
typedef unsigned v2u __attribute__((ext_vector_type(2)));
struct Args { const float* in[N_IN]; float* out; unsigned char* ws; int never; int pad; };
struct Frame {
    LAS unsigned char* lds; volatile LAS unsigned* MISC; gu32* ctl;
    int tid, lane, wave, vcu, G, gw, NGW;
    float* out; unsigned char* ws;
};
__device__ __forceinline__ const float* ld_in(const int i) {
    auto kp = __builtin_amdgcn_kernarg_segment_ptr(); unsigned long long v;
    asm volatile("s_load_dwordx2 %0, %1, %2\n\ts_waitcnt lgkmcnt(0)" : "=s"(v) : "s"(kp), "i"(i * 8) : "memory");
    return (const float*)v;
}
__device__ __forceinline__ float bf2f(unsigned short b) { return __builtin_bit_cast(float, (unsigned)b << 16); }
__device__ __forceinline__ float bflo(unsigned u) { return __builtin_bit_cast(float, u << 16); }
__device__ __forceinline__ float bfhi(unsigned u) { return __builtin_bit_cast(float, u & 0xffff0000u); }
typedef __bf16 bf16x2_t __attribute__((ext_vector_type(2)));
__device__ __forceinline__ unsigned cvtpk(float lo, float hi) { f32x2 v = {lo, hi}; bf16x2_t b = __builtin_convertvector(v, bf16x2_t); return __builtin_bit_cast(unsigned, b); }
__device__ __forceinline__ float fexp2(float x) { return __builtin_amdgcn_exp2f(x); }
__device__ __forceinline__ float fexp(float x) { return __builtin_amdgcn_exp2f(x * LOG2E); }
__device__ __forceinline__ float frcp(float x) { return __builtin_amdgcn_rcpf(x); }
__device__ __forceinline__ float fsilu(float x) { return x * frcp(1.0f + fexp(-x)); }
__device__ __forceinline__ f32x4 mfma16(bf16x8 a, bf16x8 b, f32x4 c) { return __builtin_amdgcn_mfma_f32_16x16x32_bf16(a, b, c, 0, 0, 0); }

__device__ __forceinline__ void p0_transpose_item(const float* W, int K, int N, bf16* WT, int row_off, const float* gk, LAS float* scr, int item, int lane) {
    const int nblk = N / 32, kb = item / nblk, nb = item % nblk, k0 = 64 * kb, n0 = 32 * nb;
#pragma unroll 8
    for (int i = 0; i < 32; ++i) { const int kk = 2 * i + (lane >> 5); float v = W[(size_t)(k0 + kk) * N + n0 + (lane & 31)]; if (gk) v *= gk[k0 + kk]; scr[kk * 33 + (lane & 31)] = v; }
    LDS_WAIT(); asm volatile("" ::: "memory");
    const int c = lane & 7;
#pragma unroll
    for (int j = 0; j < 4; ++j) { const int n = (lane >> 3) + 8 * j; const LAS float* s = scr + (8 * c) * 33 + n;
        v4u o; o.x = pk2(s[0 * 33], s[1 * 33]); o.y = pk2(s[2 * 33], s[3 * 33]); o.z = pk2(s[4 * 33], s[5 * 33]); o.w = pk2(s[6 * 33], s[7 * 33]);
        *(GAS v4u*)(WT + (size_t)(row_off + n0 + n) * K + k0 + 8 * c) = o; }
    LDS_WAIT(); asm volatile("" ::: "memory");
}
__device__ __forceinline__ void rms_row_to_bf16(const float* xrow, const float* g, bf16* orow, int lane) {
    const GAS f32x4* xr = (const GAS f32x4*)xrow + lane; const GAS f32x4* gr = (const GAS f32x4*)g + lane;
    f32x4 v[4]; float s = 0.f;
#pragma unroll
    for (int j = 0; j < 4; ++j) { v[j] = xr[64 * j]; s += (v[j].x * v[j].x + v[j].y * v[j].y) + (v[j].z * v[j].z + v[j].w * v[j].w); }
    const float rstd = __builtin_amdgcn_rsqf(wave_sum(s) * (1.f / 1024.f) + EPS);
    GAS unsigned long long* o8 = (GAS unsigned long long*)orow + lane;
#pragma unroll
    for (int j = 0; j < 4; ++j) { const f32x4 gg = gr[64 * j]; o8[64 * j] = (unsigned long long)pk2(v[j].x * rstd * gg.x, v[j].y * rstd * gg.y) | ((unsigned long long)pk2(v[j].z * rstd * gg.z, v[j].w * rstd * gg.w) << 32); }
}
__device__ __forceinline__ void p0_prologue(Frame& F) {
    LAS float* scr = (LAS float*)(F.lds + F.wave * 16384);
    bf16* WIN = (bf16*)(F.ws + WS_WIN); bf16* WOUT = (bf16*)(F.ws + WS_WOUT); bf16* WKVQ = (bf16*)(F.ws + WS_WKVQ); bf16* WBOUT = (bf16*)(F.ws + WS_WBOUT);
    constexpr int I1 = (1024 / 64) * (NIN / 32), I2 = (2048 / 64) * (1024 / 32), I3 = (1024 / 64) * (2048 / 32), I4 = (1024 / 64) * (4096 / 32), I5 = (1024 / 64) * (1024 / 32);
    constexpr int NITEMS = I1 + I2 + I3 + I4 + I5;
    for (int it = F.gw; it < NITEMS * REP_E; it += F.NGW) {
        int r = it % NITEMS;
        if (r < I1) { p0_transpose_item(ld_in(I_AWIN), 1024, NIN, WIN, 0, nullptr, scr, r, F.lane); continue; } r -= I1;
        if (r < I2) { p0_transpose_item(ld_in(I_AWOUT), 2048, 1024, WOUT, 0, ld_in(I_AGN), scr, r, F.lane); continue; } r -= I2;
        if (r < I3) { p0_transpose_item(ld_in(I_WKV), 1024, 2048, WKVQ, 0, ld_in(I_KVN), scr, r, F.lane); continue; } r -= I3;
        if (r < I4) { p0_transpose_item(ld_in(I_BWIN), 1024, 4096, WKVQ, 2048, ld_in(I_BN), scr, r, F.lane); continue; } r -= I4;
        p0_transpose_item(ld_in(I_BWOUT), 1024, 1024, WBOUT, 0, nullptr, scr, r, F.lane);
    }
    bf16* XN = (bf16*)(F.ws + WS_XN);
    for (int m_ = F.gw; m_ < (MP + MS) * REP_E; m_ += F.NGW) { const int m = m_ % (MP + MS);
        const float* xr = m < MP ? ld_in(I_XP) + (size_t)m * DM : ld_in(I_XS) + (size_t)(m - MP) * DM;
        rms_row_to_bf16(xr, ld_in(I_ANORM), XN + (size_t)m * DM, F.lane);
    }
}
template <class Fn> __device__ __forceinline__ void wave_tile_gemm(const bf16* A, int lda, const bf16* Bt, int ldb, int K, int m0, int n0, int lane, Fn&& f) {
    const int r16 = lane & 15, g = lane >> 4;
    const bf16* ap = A + (size_t)(m0 + r16) * lda + 8 * g; const bf16* bp = Bt + (size_t)(n0 + r16) * ldb + 8 * g;
    f32x4 acc = {0.f, 0.f, 0.f, 0.f};
    for (int k0 = 0; k0 < K; k0 += 256) {
        bf16x8 a[8], b[8];
#pragma unroll
        for (int i = 0; i < 8; ++i) { a[i] = *(const bf16x8*)(ap + k0 + 32 * i); b[i] = *(const bf16x8*)(bp + k0 + 32 * i); }
#pragma unroll
        for (int i = 0; i < 8; ++i) acc = mfma16(a[i], b[i], acc);
    }
#pragma unroll
    for (int r = 0; r < 4; ++r) f(m0 + 4 * g + r, n0 + r16, acc[r]);
}
__device__ __forceinline__ void p1_small(Frame& F) {
    const bf16* XN = (const bf16*)(F.ws + WS_XN); const bf16* WIN = (const bf16*)(F.ws + WS_WIN);
    float* DT = (float*)(F.ws + WS_DT); float* US = (float*)(F.ws + WS_US);
    constexpr int T1 = (MS / 16) * (NIN / 16), T2 = (MP / 16) * 2;
    for (int t_ = F.gw; t_ < (T1 + T2) * REP_D; t_ += F.NGW) { const int t = t_ % (T1 + T2);
        if (t < T1) { const int mt = t % (MS / 16), nt = t / (MS / 16);
            wave_tile_gemm(XN + (size_t)MP * DM, DM, WIN, DM, DM, mt * 16, nt * 16, F.lane, [&](int r, int c, float v) { US[(size_t)r * NIN + c] = v; });
        } else { const int q = t - T1, mt = q >> 1, nt = q & 1;
            wave_tile_gemm(XN, DM, WIN + (size_t)5120 * DM, DM, DM, mt * 16, nt * 16, F.lane, [&](int r, int c, float v) { DT[(size_t)r * 32 + c] = v; });
        }
    }
}
constexpr int STR128 = 288, STR64 = 160;
__device__ __forceinline__ s16x4 tr_read(const LAS unsigned char* p) { typedef short v4s __attribute__((ext_vector_type(4))); return __builtin_bit_cast(s16x4, __builtin_amdgcn_ds_read_tr16_b64_v4i16((LAS v4s*)p)); }
__device__ __forceinline__ bf16x8 tr_frag(const LAS unsigned char* tile, int stride, int k0, int m0, int lane) {
    const int g = lane >> 4, q = (lane >> 2) & 3, p = lane & 3;
    const LAS unsigned char* a = tile + (k0 + 4 * g + q) * stride + (m0 + 4 * p) * 2;
    const s16x4 lo = tr_read(a), hi = tr_read(a + 16 * stride);
    return (bf16x8){lo[0], lo[1], lo[2], lo[3], hi[0], hi[1], hi[2], hi[3]};
}
__device__ __forceinline__ int t5_bucket(int n) {
    if (n < 16) return n;
    const int large = 16 + (int)(logf((float)n / 16.0f) / 4.852030263919617f * 16.0f);
    return large < 31 ? large : 31;
}
__device__ __forceinline__ float softplus_f(float x) { return fmaxf(x, 0.f) + log1pf(expf(-fabsf(x))); }
__device__ __forceinline__ void unpack8(const v4u u, float (&f)[8]) { f[0] = bflo(u.x); f[1] = bfhi(u.x); f[2] = bflo(u.y); f[3] = bfhi(u.y); f[4] = bflo(u.z); f[5] = bfhi(u.z); f[6] = bflo(u.w); f[7] = bfhi(u.w); }

template <int NR> __device__ __forceinline__ void conv_cols(const bf16* XBC, bf16* ACT, const float* cw, const float* cb, int R0, int seq_t0, int col, int t0,
                                          LAS unsigned char* ldst, int lstride, const LAS float* wscale, const int lmode) {
    v4u raw[NR + 3];
#pragma unroll
    for (int k = 0; k < NR + 3; ++k) { raw[k] = (v4u){0u, 0u, 0u, 0u}; if (seq_t0 + t0 - 3 + k >= 0) raw[k] = *(const v4u*)(XBC + (size_t)(R0 + t0 - 3 + k) * CD + col); }
    float w[4][8], bias[8], h0[8], h1[8], h2[8];
#pragma unroll
    for (int k = 0; k < 4; ++k) { const f32x4 a = *(const f32x4*)(cw + k * CD + col), b = *(const f32x4*)(cw + k * CD + col + 4);
        w[k][0] = a[0]; w[k][1] = a[1]; w[k][2] = a[2]; w[k][3] = a[3]; w[k][4] = b[0]; w[k][5] = b[1]; w[k][6] = b[2]; w[k][7] = b[3]; }
    { const f32x4 a = *(const f32x4*)(cb + col), b = *(const f32x4*)(cb + col + 4); bias[0] = a[0]; bias[1] = a[1]; bias[2] = a[2]; bias[3] = a[3]; bias[4] = b[0]; bias[5] = b[1]; bias[6] = b[2]; bias[7] = b[3]; }
    unpack8(raw[0], h0); unpack8(raw[1], h1); unpack8(raw[2], h2);
#pragma unroll
    for (int tt = 0; tt < NR; ++tt) { const int t = t0 + tt;
        float x[8], a[8]; unpack8(raw[tt + 3], x);
#pragma unroll
        for (int e = 0; e < 8; ++e) { float c = bias[e] + h0[e] * w[0][e]; c += h1[e] * w[1][e]; c += h2[e] * w[2][e]; c += x[e] * w[3][e]; a[e] = fsilu(c); h0[e] = h1[e]; h1[e] = h2[e]; h2[e] = x[e]; }
        v4u o; o.x = cvtpk(a[0], a[1]); o.y = cvtpk(a[2], a[3]); o.z = cvtpk(a[4], a[5]); o.w = cvtpk(a[6], a[7]);
        *(v4u*)(ACT + (size_t)(R0 + t) * CD + col) = o;
        if (lmode) { if (lmode == 2) { const float s = wscale[t]; o.x = cvtpk(a[0] * s, a[1] * s); o.y = cvtpk(a[2] * s, a[3] * s); o.z = cvtpk(a[4] * s, a[5] * s); o.w = cvtpk(a[6] * s, a[7] * s); }
            *(LAS v4u*)(ldst + t * lstride) = o; }
    }
}

__device__ __forceinline__ void p2_ssd_a(Frame& F) {
    const bf16* XBC = (const bf16*)(F.ws + WS_XBC); bf16* ACT = (bf16*)(F.ws + WS_ACT);
    const float* DT = (const float*)(F.ws + WS_DT); float* DTV = (float*)(F.ws + WS_DTV); float* ACS = (float*)(F.ws + WS_ACS); bf16* CS = (bf16*)(F.ws + WS_CS);
    const float* cw = ld_in(I_ACONVW); const float* cb = ld_in(I_ACONVB);
    LAS unsigned char* Bt = F.lds;
    LAS unsigned char* Xt = F.lds + 36864;
    LAS float* wtab = (LAS float*)(F.lds + LDS_X_OFF);
    const int lane = F.lane, w = F.wave, tid = F.tid;
    for (int item_ = F.vcu; item_ < NBATCH * NCH * 4 * REP_A; item_ += F.G) { const int item = item_ & 511;
        const int b = item >> 7, c = (item >> 2) & 31, g = item & 3, R0 = b * SEQ + c * 128, seq0 = c * 128;
        { const int h = 8 * g + w; const float dtb = ld_in(I_ADTB)[h], a = -expf(ld_in(I_AALOG)[h]);
          const int s0 = 2 * lane;
          const float d0 = softplus_f(DT[(size_t)(R0 + s0) * 32 + h] + dtb), d1 = softplus_f(DT[(size_t)(R0 + s0 + 1) * 32 + h] + dtb);
          const float a0 = d0 * a, a1 = d1 * a; float v = a0 + a1;
#pragma unroll
          for (int o = 1; o < 64; o <<= 1) { const float t = __shfl_up(v, o); if (lane >= o) v += t; }
          const float c1 = v, c0 = v - a1, cend = __shfl(v, 63);
          DTV[(size_t)(R0 + s0) * 32 + h] = d0; DTV[(size_t)(R0 + s0 + 1) * 32 + h] = d1; ACS[(size_t)(R0 + s0) * 32 + h] = c0; ACS[(size_t)(R0 + s0 + 1) * 32 + h] = c1;
          wtab[w * 128 + s0] = fexp(cend - c0) * d0; wtab[w * 128 + s0 + 1] = fexp(cend - c1) * d1; }
        __syncthreads();
#pragma unroll 1
        for (int pass = 0; pass < 2; ++pass) {
            if (pass == 0) { int col, lmode, lstride; LAS unsigned char* ld; const LAS float* ws_; const int cg = tid & 63, rs = tid >> 6;
                if (cg < 16) { col = 2048 + 128 * g + 8 * cg; ld = Bt + cg * 16; lstride = STR128; ws_ = wtab; lmode = 1; }
                else if (cg < 32) { col = 2560 + 128 * g + 8 * (cg - 16); ld = Bt; lstride = 0; ws_ = wtab; lmode = 0; }
                else { const int xc = cg - 32, hh = xc >> 3; col = 512 * g + 8 * xc; ld = Xt + hh * 20480 + (xc & 7) * 16; lstride = STR64; ws_ = wtab + hh * 128; lmode = 2; }
#pragma unroll 1
                for (int hf = 0; hf < 2; ++hf) conv_cols<8>(XBC, ACT, cw, cb, R0, seq0, col, 16 * rs + 8 * hf, ld, lstride, ws_, lmode);
            } else { const int xc = tid & 31, rs = tid >> 5, hh = xc >> 3;
                conv_cols<8>(XBC, ACT, cw, cb, R0, seq0, 512 * g + 256 + 8 * xc, 8 * rs, Xt + hh * 20480 + (xc & 7) * 16, STR64, wtab + (4 + hh) * 128, 2); }
            __syncthreads();
            const int hh = w & 3, nh = w >> 2, h = 8 * g + 4 * pass + hh;
            f32x4 acc[4][4];
#pragma unroll
            for (int i = 0; i < 4; ++i)
#pragma unroll
                for (int j = 0; j < 4; ++j) acc[i][j] = (f32x4){0.f, 0.f, 0.f, 0.f};
#pragma unroll
            for (int ks = 0; ks < 4; ++ks) { bf16x8 xa[4], bb[4];
#pragma unroll
                for (int mt = 0; mt < 4; ++mt) xa[mt] = tr_frag(Xt + hh * 20480, STR64, 32 * ks, 16 * mt, lane);
#pragma unroll
                for (int nt = 0; nt < 4; ++nt) bb[nt] = tr_frag(Bt, STR128, 32 * ks, 64 * nh + 16 * nt, lane);
#pragma unroll
                for (int nt = 0; nt < 4; ++nt)
#pragma unroll
                    for (int mt = 0; mt < 4; ++mt) acc[nt][mt] = mfma16(bb[nt], xa[mt], acc[nt][mt]); }
            bf16* cs = CS + ((size_t)((b * NCH + c) * NH + h) * HP) * NS;
#pragma unroll
            for (int nt = 0; nt < 4; ++nt)
#pragma unroll
                for (int mt = 0; mt < 4; ++mt) { const f32x4 a = acc[nt][mt]; v2u o; o.x = cvtpk(a[0], a[1]); o.y = cvtpk(a[2], a[3]);
                    *(v2u*)(cs + (size_t)(16 * mt + (lane & 15)) * NS + 64 * nh + 16 * nt + 4 * (lane >> 4)) = o; }
            __syncthreads();
        }
    }
}

__device__ __forceinline__ void p2_sample(Frame& F) {
    const float* US = (const float*)(F.ws + WS_US); bf16* YGS = (bf16*)(F.ws + WS_YGS); float* SSQGS = (float*)(F.ws + WS_SSQGS);
    const float* cw = ld_in(I_ACONVW); const float* cb = ld_in(I_ACONVB); const float* sconv = ld_in(I_CONV); const float* sssm = ld_in(I_SSM);
    LAS float* L = (LAS float*)F.lds;
    const int lane = F.lane, w = F.wave, tid = F.tid;
    for (int item_ = F.vcu; item_ < SB * NH * REP_D; item_ += F.G) { const int item = item_ & 1023;
        const int sb = item >> 5, h = item & 31, g = h >> 3;
        f32x4 s4[4];
        { const f32x4* sp = (const f32x4*)(sssm + ((size_t)(sb * NH + h) * HP + lane) * NS + 16 * w);
#pragma unroll
          for (int k = 0; k < 4; ++k) s4[k] = sp[k]; }
        if (tid < 256) L[1296 + tid] = US[(size_t)(sb * 4 + (tid >> 6)) * NIN + h * 64 + (tid & 63)];
        if (tid < 320) { const int col = tid < 64 ? h * 64 + tid : (tid < 192 ? 2048 + g * 128 + (tid - 64) : 2560 + g * 128 + (tid - 192));
            float xc[7];
#pragma unroll
            for (int k = 0; k < 3; ++k) xc[k] = sconv[((size_t)sb * 3 + k) * CD + col];
#pragma unroll
            for (int t = 0; t < 4; ++t) xc[3 + t] = US[(size_t)(sb * 4 + t) * NIN + 2048 + col];
            const float w0 = cw[col], w1 = cw[CD + col], w2 = cw[2 * CD + col], w3 = cw[3 * CD + col], bb = cb[col];
#pragma unroll
            for (int t = 0; t < 4; ++t) { const float cv = bb + xc[t] * w0 + xc[t + 1] * w1 + xc[t + 2] * w2 + xc[t + 3] * w3; const float a = fsilu(cv);
                if (tid < 64) L[t * 64 + tid] = a; else if (tid < 192) L[256 + t * 128 + (tid - 64)] = a; else L[768 + t * 128 + (tid - 192)] = a; }
        } else if (tid < 324) { const int t = tid - 320; const float d = softplus_f(US[(size_t)(sb * 4 + t) * NIN + 5120 + h] + ld_in(I_ADTB)[h]);
            L[1280 + t] = d; L[1284 + t] = expf(d * (-expf(ld_in(I_AALOG)[h]))); }
        if (h == 0) { float* cs = F.out + O_CONVS + (size_t)sb * 3 * CD;
            for (int e = tid; e < 3 * CD; e += NWAVES * 64) { const int j = e / CD, col = e - j * CD; cs[e] = US[(size_t)(sb * 4 + 1 + j) * NIN + 2048 + col]; } }
        __syncthreads();
#pragma unroll
        for (int t = 0; t < 4; ++t) { const float dA = L[1284 + t], xd = L[1280 + t] * L[t * 64 + lane]; float y = 0.f;
#pragma unroll
            for (int k = 0; k < 4; ++k) { const f32x4 bv = *(const LAS f32x4*)(L + 256 + t * 128 + 16 * w + 4 * k), cv = *(const LAS f32x4*)(L + 768 + t * 128 + 16 * w + 4 * k);
#pragma unroll
                for (int e = 0; e < 4; ++e) { s4[k][e] = dA * s4[k][e] + xd * bv[e]; y += cv[e] * s4[k][e]; } }
            L[1552 + (w * 4 + t) * 64 + lane] = y; }
        { f32x4* op = (f32x4*)(F.out + O_SSMS + ((size_t)(sb * NH + h) * HP + lane) * NS + 16 * w);
#pragma unroll
          for (int k = 0; k < 4; ++k) op[k] = s4[k]; }
        __syncthreads();
        if (tid < 256) { const int t = tid >> 6, p = tid & 63; float y = 0.f;
#pragma unroll
            for (int ww = 0; ww < 8; ++ww) y += L[1552 + (ww * 4 + t) * 64 + p];
            y += ld_in(I_AD)[h] * L[t * 64 + p]; const float yg = y * fsilu(L[1296 + tid]); const int row = sb * 4 + t;
            YGS[(size_t)row * SI + h * 64 + p] = (bf16)f2bf(yg);
            const float q = wave_sum(yg * yg); if (lane == 0) SSQGS[(size_t)row * 32 + h] = q; }
        __syncthreads();
    }
}

__device__ __forceinline__ void p3_scan(Frame& F) {
    bf16* CS = (bf16*)(F.ws + WS_CS); const float* ACS = (const float*)(F.ws + WS_ACS);
    const int gt = F.vcu * (NWAVES * 64) + F.tid, NT = F.G * NWAVES * 64;
    for (int e_ = gt; e_ < NBATCH * NH * HP * NS / 4 * REP_E; e_ += NT) { const int e = e_ & 262143;
        const int n4 = e & 31, p = (e >> 5) & 63, h = (e >> 11) & 31, b = e >> 16;
        f32x4 s = {0.f, 0.f, 0.f, 0.f};
#pragma unroll 1
        for (int c0 = 0; c0 < NCH; c0 += 8) { v2u cs[8]; float dec[8];
#pragma unroll
            for (int k = 0; k < 8; ++k) { const size_t off = (((size_t)(b * NCH + c0 + k) * NH + h) * HP + p) * NS + 4 * n4; cs[k] = *(const v2u*)(CS + off); dec[k] = ACS[(size_t)(b * SEQ + (c0 + k) * 128 + 127) * 32 + h]; }
#pragma unroll
            for (int k = 0; k < 8; ++k) { const size_t off = (((size_t)(b * NCH + c0 + k) * NH + h) * HP + p) * NS + 4 * n4;
                v2u o; o.x = cvtpk(s[0], s[1]); o.y = cvtpk(s[2], s[3]); *(v2u*)(CS + off) = o;
                const float d = fexp(dec[k]); s[0] = s[0] * d + bflo(cs[k].x); s[1] = s[1] * d + bfhi(cs[k].x); s[2] = s[2] * d + bflo(cs[k].y); s[3] = s[3] * d + bfhi(cs[k].y); } }
        *(f32x4*)(F.out + O_SSMP + (((size_t)(b * NH + h)) * HP + p) * NS + 4 * n4) = s;
    }
}
__device__ __forceinline__ void p4_ssd_b(Frame& F) {
    const bf16* ACT = (const bf16*)(F.ws + WS_ACT); const bf16* Z = (const bf16*)(F.ws + WS_Z); const bf16* SIN = (const bf16*)(F.ws + WS_SIN);
    const float* DTV = (const float*)(F.ws + WS_DTV); const float* ACS = (const float*)(F.ws + WS_ACS); bf16* YG = (bf16*)(F.ws + WS_YG); float* SSQG = (float*)(F.ws + WS_SSQG);
    LAS unsigned char* Xt = F.lds;
    const int lane = F.lane, w = F.wave, tid = F.tid, i = lane & 15, gq = lane >> 4;
    LAS float* stg = (LAS float*)(F.lds + 81920 + w * 4352);
    LAS float* acsT = (LAS float*)(F.lds + LDS_X_OFF); LAS float* dtvT = acsT + 1024;
    for (int item_ = F.vcu; item_ < NBATCH * NCH * 4 * REP_A; item_ += F.G) { const int item = item_ & 511;
        const int b = item >> 7, c = (item >> 2) & 31, g = item & 3, R0 = b * SEQ + c * 128;
        for (int e = tid; e < 1024; e += NWAVES * 64) { const int h8 = e >> 7, s = e & 127; acsT[e] = ACS[(size_t)(R0 + s) * 32 + 8 * g + h8]; dtvT[e] = DTV[(size_t)(R0 + s) * 32 + 8 * g + h8]; }
        bf16x8 cf[4];
#pragma unroll
        for (int kn = 0; kn < 4; ++kn) cf[kn] = *(const bf16x8*)(ACT + (size_t)(R0 + 16 * w + i) * CD + 2560 + 128 * g + 32 * kn + 8 * gq);
        f32x4 cbt[8];
#pragma unroll
        for (int st = 0; st < 8; ++st) { f32x4 a = {0.f, 0.f, 0.f, 0.f};
            if (st <= w) {
#pragma unroll
                for (int kn = 0; kn < 4; ++kn) { const bf16x8 bf = *(const bf16x8*)(ACT + (size_t)(R0 + 16 * st + i) * CD + 2048 + 128 * g + 32 * kn + 8 * gq); a = mfma16(bf, cf[kn], a); } }
            cbt[st] = a; }
        float ssq = 0.f;
        const int tr = lane >> 2, pc = lane & 3;
#pragma unroll 1
        for (int pass = 0; pass < 2; ++pass) {
            for (int e = tid; e < 4096; e += NWAVES * 64) { const int s = e >> 5, cc = e & 31;
                *(LAS v4u*)(Xt + (cc >> 3) * 20480 + s * STR64 + (cc & 7) * 16) = *(const v4u*)(ACT + (size_t)(R0 + s) * CD + 512 * g + 256 * pass + 8 * cc); }
            __syncthreads();
#pragma unroll 1
            for (int hh = 0; hh < 4; ++hh) { const int hl = 4 * pass + hh, h = 8 * g + hl;
                const LAS unsigned char* Xh = Xt + hh * 20480;
                const float ea_t = acsT[hl * 128 + 16 * w + i];
                bf16x8 lf[4];
#pragma unroll
                for (int ks = 0; ks < 4; ++ks) { float v[8];
#pragma unroll
                    for (int half = 0; half < 2; ++half) { const int st = 2 * ks + half;
                        if (st <= w) { const f32x4 a4 = *(const LAS f32x4*)(acsT + hl * 128 + 16 * st + 4 * gq), d4 = *(const LAS f32x4*)(dtvT + hl * 128 + 16 * st + 4 * gq);
#pragma unroll
                            for (int r = 0; r < 4; ++r) { float x = cbt[st][r] * fexp(ea_t - a4[r]) * d4[r]; if (st == w && 4 * gq + r > i) x = 0.f; v[4 * half + r] = x; }
                        } else {
#pragma unroll
                            for (int r = 0; r < 4; ++r) v[4 * half + r] = 0.f; } }
                    v4u pk; pk.x = cvtpk(v[0], v[1]); pk.y = cvtpk(v[2], v[3]); pk.z = cvtpk(v[4], v[5]); pk.w = cvtpk(v[6], v[7]); lf[ks] = __builtin_bit_cast(bf16x8, pk); }
                f32x4 yd[4], yo[4];
#pragma unroll
                for (int pt = 0; pt < 4; ++pt) { yd[pt] = (f32x4){0.f, 0.f, 0.f, 0.f}; yo[pt] = (f32x4){0.f, 0.f, 0.f, 0.f}; }
#pragma unroll
                for (int ks = 0; ks < 4; ++ks) if (2 * ks <= w) {
#pragma unroll
                    for (int pt = 0; pt < 4; ++pt) { const bf16x8 xb = tr_frag(Xh, STR64, 32 * ks, 16 * pt, lane); yd[pt] = mfma16(lf[ks], xb, yd[pt]); } }
                const bf16* sp = SIN + ((size_t)((b * NCH + c) * NH + h) * HP + i) * NS + 8 * gq;
#pragma unroll
                for (int kn = 0; kn < 4; ++kn)
#pragma unroll
                    for (int pt = 0; pt < 4; ++pt) { const bf16x8 sf = *(const bf16x8*)(sp + (size_t)(16 * pt) * NS + 32 * kn); yo[pt] = mfma16(cf[kn], sf, yo[pt]); }
                const f32x4 ea4 = *(const LAS f32x4*)(acsT + hl * 128 + 16 * w + 4 * gq);
#pragma unroll
                for (int r = 0; r < 4; ++r) { const float er = fexp(ea4[r]);
#pragma unroll
                    for (int pt = 0; pt < 4; ++pt) stg[(4 * gq + r) * 68 + 16 * pt + i] = yd[pt][r] + er * yo[pt][r]; }
                const int row = R0 + 16 * w + tr; const float Dh = ld_in(I_AD)[h];
                float y[16], x[16], z[16];
#pragma unroll
                for (int q = 0; q < 4; ++q) { const f32x4 t4 = *(const LAS f32x4*)(stg + tr * 68 + 16 * pc + 4 * q); y[4 * q] = t4[0]; y[4 * q + 1] = t4[1]; y[4 * q + 2] = t4[2]; y[4 * q + 3] = t4[3]; }
                { const LAS v4u* xp = (const LAS v4u*)(Xh + (16 * w + tr) * STR64 + pc * 32); float t8[8]; unpack8(xp[0], t8);
#pragma unroll
                  for (int e = 0; e < 8; ++e) x[e] = t8[e];
                  unpack8(xp[1], t8);
#pragma unroll
                  for (int e = 0; e < 8; ++e) x[8 + e] = t8[e]; }
                { const v4u* zp = (const v4u*)(Z + (size_t)row * SI + h * 64 + 16 * pc); float t8[8]; unpack8(zp[0], t8);
#pragma unroll
                  for (int e = 0; e < 8; ++e) z[e] = t8[e];
                  unpack8(zp[1], t8);
#pragma unroll
                  for (int e = 0; e < 8; ++e) z[8 + e] = t8[e]; }
#pragma unroll
                for (int e = 0; e < 16; ++e) { const float yy = (y[e] + Dh * x[e]) * fsilu(z[e]); y[e] = yy; ssq += yy * yy; }
                v4u o0, o1; o0.x = cvtpk(y[0], y[1]); o0.y = cvtpk(y[2], y[3]); o0.z = cvtpk(y[4], y[5]); o0.w = cvtpk(y[6], y[7]); o1.x = cvtpk(y[8], y[9]); o1.y = cvtpk(y[10], y[11]); o1.z = cvtpk(y[12], y[13]); o1.w = cvtpk(y[14], y[15]);
                v4u* op = (v4u*)(YG + (size_t)row * SI + h * 64 + 16 * pc); op[0] = o0; op[1] = o1;
            }
            __syncthreads();
        }
        ssq += __shfl_xor(ssq, 1); ssq += __shfl_xor(ssq, 2);
        if (pc == 0) SSQG[(size_t)(R0 + 16 * w + tr) * 4 + g] = ssq;
    }
}

__device__ __forceinline__ f32x4 wave_tile_gemm_ss(const bf16* A, int lda, const bf16* Bt, int ldb, int K, int m0, int n0, int lane, float& ss) {
    const int r16 = lane & 15, g = lane >> 4;
    const bf16* ap = A + (size_t)(m0 + r16) * lda + 8 * g; const bf16* bp = Bt + (size_t)(n0 + r16) * ldb + 8 * g;
    f32x4 acc = {0.f, 0.f, 0.f, 0.f}; float q = 0.f;
    for (int k0 = 0; k0 < K; k0 += 256) {
        bf16x8 a[8], b[8];
#pragma unroll
        for (int i = 0; i < 8; ++i) { a[i] = *(const bf16x8*)(ap + k0 + 32 * i); b[i] = *(const bf16x8*)(bp + k0 + 32 * i); }
#pragma unroll
        for (int i = 0; i < 8; ++i) { acc = mfma16(a[i], b[i], acc); float t8[8]; unpack8(__builtin_bit_cast(v4u, a[i]), t8);
#pragma unroll
            for (int e = 0; e < 8; ++e) q += t8[e] * t8[e]; }
    }
    q += __shfl_xor(q, 16); q += __shfl_xor(q, 32); ss = q; return acc;
}
__device__ __forceinline__ void p3_sample(Frame& F) {
    const bf16* YGS = (const bf16*)(F.ws + WS_YGS); const bf16* WOUT = (const bf16*)(F.ws + WS_WOUT); const float* SSQGS = (const float*)(F.ws + WS_SSQGS);
    float* HS1 = (float*)(F.ws + WS_HS1); bf16* HS1B = (bf16*)(F.ws + WS_HS1B); const float* xs = ld_in(I_XS);
    for (int t_ = F.gw; t_ < (MS / 16) * (DM / 16) * REP_D; t_ += F.NGW) { const int t = t_ & 511; const int mt = t & 7, nt = t >> 3; const int lane = F.lane, gq = lane >> 4;
        float rs[4];
#pragma unroll
        for (int r = 0; r < 4; ++r) { const f32x4* sp = (const f32x4*)(SSQGS + (size_t)(mt * 16 + 4 * gq + r) * 32); float q = 0.f;
#pragma unroll
            for (int k = 0; k < 8; ++k) { const f32x4 v = sp[k]; q += (v[0] + v[1]) + (v[2] + v[3]); }
            rs[r] = __builtin_amdgcn_rsqf(q * (1.f / 2048.f) + EPS); }
        int rr = 0;
        wave_tile_gemm(YGS, SI, WOUT, SI, SI, mt * 16, nt * 16, lane, [&](int r, int c, float v) { const float h = xs[(size_t)r * DM + c] + v * rs[rr]; ++rr; HS1[(size_t)r * DM + c] = h; HS1B[(size_t)r * DM + c] = (bf16)f2bf(h); });
    }
}
__device__ __forceinline__ void p4_sample(Frame& F) {
    const bf16* HS1B = (const bf16*)(F.ws + WS_HS1B); const bf16* WKVQ = (const bf16*)(F.ws + WS_WKVQ); float* KVQS = (float*)(F.ws + WS_KVQS);
    for (int t_ = F.gw; t_ < (MS / 16) * (NKVQ / 16) * REP_D; t_ += F.NGW) { const int t = t_ % 3072; const int mt = t & 7, nt = t >> 3; const int lane = F.lane, gq = lane >> 4, i = lane & 15;
        float ss; const f32x4 acc = wave_tile_gemm_ss(HS1B, DM, WKVQ, DM, DM, mt * 16, nt * 16, lane, ss);
        const float rsl = __builtin_amdgcn_rsqf(ss * (1.f / 1024.f) + EPS);
#pragma unroll
        for (int r = 0; r < 4; ++r) { const float rs = __shfl(rsl, 4 * gq + r); const int row = mt * 16 + 4 * gq + r, col = nt * 16 + i; const float v = acc[r] * rs;
            KVQS[(size_t)row * NKVQ + col] = v; if (col < 2048) F.out[O_KVS + (size_t)row * 2048 + col] = v; }
    }
}
__device__ __forceinline__ void p5_sample_attn(Frame& F) {
    const float* KVQS = (const float*)(F.ws + WS_KVQS); const float* cache = ld_in(I_CACHE); bf16* AOS = (bf16*)(F.ws + WS_AOS);
    LAS float* qv = (LAS float*)F.lds; LAS float* sc = qv + 1536; LAS float* bt = sc + 1584; LAS float* lse = bt + 396; LAS float* po = lse + 16;
    for (int item_ = F.vcu; item_ < SB * 8 * REP_C; item_ += F.G) { const int item = item_ & 255; const int sb = item >> 3, h = item & 7;
        int tid = F.tid; asm volatile("" : "+v"(tid));
        const int lane = tid & 63, w = F.wave;
        const float* cbase = cache + (size_t)sb * 2048 * 2048 + h * 128; const float* nbase = KVQS + (size_t)sb * 4 * NKVQ + h * 128;
        __syncthreads();
        for (int e = tid; e < 1536; e += NWAVES * 64) { const int pr = e >> 7, d = e & 127, g = pr >> 2, t = pr & 3;
            qv[e] = nbase[(unsigned)(t * NKVQ + 2048 + g * 1024 + d)] * 0.08838834764831845f; }
        for (int e = tid; e < 3 * 129; e += NWAVES * 64) { const int g = e / 129, j = e - g * 129, dil = g == 0 ? 1 : (g == 1 ? 4 : 16);
            bt[g * 132 + j] = ld_in(I_RELB)[t5_bucket(j * dil) * 24 + g * 8 + h]; }
        __syncthreads();
        const int lg = lane >> 3, sub = lane & 7;
#pragma unroll 2
        for (int it = 0; it < 25; ++it) { const int combo = it * 64 + w * 8 + lg, cc = combo < 1548 ? combo : 1547, pr = cc / 129, j = cc - pr * 129, g = pr >> 2, t = pr & 3;
            const int dil = g == 0 ? 1 : (g == 1 ? 4 : 16), idx = 2048 + t - dil * j;
            const float* kr = idx >= 2048 ? nbase + (unsigned)((idx - 2048) * NKVQ) : cbase + (unsigned)(idx * 2048);
            float dot = 0.f;
#pragma unroll
            for (int k = 0; k < 4; ++k) { const f32x4 kv = *(const f32x4*)(kr + 4 * (sub + 8 * k)); const f32x4 q4 = *(const LAS f32x4*)(qv + pr * 128 + 4 * (sub + 8 * k));
                dot += (kv[0] * q4[0] + kv[1] * q4[1]) + (kv[2] * q4[2] + kv[3] * q4[3]); }
            dot += __shfl_xor(dot, 1); dot += __shfl_xor(dot, 2); dot += __shfl_xor(dot, 4);
            if (sub == 0 && combo < 1548) sc[pr * 132 + j] = dot + bt[g * 132 + j]; }
        __syncthreads();
        for (int pr = w; pr < 12; pr += 8) { const float s0 = sc[pr * 132 + lane], s1 = sc[pr * 132 + 64 + lane], s2 = lane == 0 ? sc[pr * 132 + 128] : -1e30f;
            float m = fmaxf(s0, fmaxf(s1, s2));
#pragma unroll
            for (int o = 1; o < 64; o <<= 1) m = fmaxf(m, __shfl_xor(m, o));
            const float e0 = fexp(s0 - m), e1 = fexp(s1 - m), e2 = lane == 0 ? fexp(s2 - m) : 0.f; const float l = wave_sum(e0 + e1 + e2), rl = frcp(l);
            sc[pr * 132 + lane] = e0 * rl; sc[pr * 132 + 64 + lane] = e1 * rl; if (lane == 0) { sc[pr * 132 + 128] = e2 * rl; lse[pr] = m + __builtin_amdgcn_logf(l) * LN2; } }
        __syncthreads();
        const int hb = lane >> 5, d4 = (lane & 31) * 4;
#pragma unroll 1
        for (int pr = 0; pr < 12; ++pr) { const int g = pr >> 2, t = pr & 3, dil = g == 0 ? 1 : (g == 1 ? 4 : 16); f32x4 a = {0.f, 0.f, 0.f, 0.f};
#pragma unroll
            for (int it = 0; it < 9; ++it) { const int j = 2 * w + 16 * it + hb, jc = j < 129 ? j : 128, idx = 2048 + t - dil * jc;
                const float* vr = idx >= 2048 ? nbase + (unsigned)((idx - 2048) * NKVQ + 1024) : cbase + (unsigned)(idx * 2048 + 1024);
                const f32x4 v = *(const f32x4*)(vr + d4); const float p = j < 129 ? sc[pr * 132 + jc] : 0.f; a = a + v * p; }
#pragma unroll
            for (int e = 0; e < 4; ++e) a[e] += __shfl_xor(a[e], 32);
            if (hb == 0) *(LAS f32x4*)(po + (w * 12 + pr) * 128 + d4) = a; }
        __syncthreads();
        { const int t = tid >> 7, d = tid & 127; float og[3], lg3[3];
#pragma unroll
          for (int g = 0; g < 3; ++g) { const int pr = g * 4 + t; float s = 0.f;
#pragma unroll
              for (int ww = 0; ww < 8; ++ww) s += po[(ww * 12 + pr) * 128 + d];
              og[g] = s; lg3[g] = lse[pr]; }
          const float m = fmaxf(lg3[0], fmaxf(lg3[1], lg3[2])); const float w0 = fexp(lg3[0] - m), w1 = fexp(lg3[1] - m), w2 = fexp(lg3[2] - m);
          const float o = (w0 * og[0] + w1 * og[1] + w2 * og[2]) * frcp(w0 + w1 + w2);
          const int row = sb * 4 + t; const float gate = nbase[(unsigned)(t * NKVQ + 5120 + d)];
          AOS[(size_t)row * DM + h * 128 + d] = (bf16)f2bf(o * fsilu(gate)); }
    }
}
__device__ __forceinline__ void p6_sample(Frame& F) {
    const bf16* AOS = (const bf16*)(F.ws + WS_AOS); const bf16* WB = (const bf16*)(F.ws + WS_WBOUT); const float* HS1 = (const float*)(F.ws + WS_HS1); float* HS2 = (float*)(F.ws + WS_HS2);
    for (int t_ = F.gw; t_ < (MS / 16) * (DM / 16) * REP_D; t_ += F.NGW) { const int t = t_ & 511; const int mt = t & 7, nt = t >> 3;
        wave_tile_gemm(AOS, DM, WB, DM, DM, mt * 16, nt * 16, F.lane, [&](int r, int c, float v) { HS2[(size_t)r * DM + c] = HS1[(size_t)r * DM + c] + v; });
    }
}
constexpr int KSTR = 272, VSTR = 288, ATT_K0 = 0, ATT_V0 = 2 * 128 * KSTR  , ATT_BT = ATT_V0 + 2 * 128 * VSTR  ;
static_assert(ATT_BT + 132 * 4 <= LDSCTL_OFF, "attention LDS map");
struct HalfRegs { v4u k[4], v[4]; };
__device__ __forceinline__ void attn_fetch_half(Frame& F, HalfRegs& R, const bf16* Kh, const bf16* Vh, int m, int res, int dil) {
#pragma unroll
    for (int k = 0; k < 4; ++k) { const int e = F.tid + 512 * k, kr = e >> 4, ch = e & 15;
        R.k[k] = (v4u){0u, 0u, 0u, 0u}; R.v[k] = (v4u){0u, 0u, 0u, 0u};
        if (m >= 0) { const size_t off = (size_t)(res + dil * (128 * m + kr)) * 128 + 8 * ch; R.k[k] = *(const v4u*)(Kh + off); R.v[k] = *(const v4u*)(Vh + off); } }
}
__device__ __forceinline__ void attn_store_half(Frame& F, const HalfRegs& R, int m) {
    LAS unsigned char* kb = F.lds + ATT_K0 + (m & 1) * (128 * KSTR); LAS unsigned char* vb = F.lds + ATT_V0 + (m & 1) * (128 * VSTR);
#pragma unroll
    for (int k = 0; k < 4; ++k) { const int e = F.tid + 512 * k, kr = e >> 4, ch = e & 15;
        *(LAS v4u*)(kb + kr * KSTR + ch * 16) = R.k[k]; *(LAS v4u*)(vb + kr * VSTR + ch * 16) = R.v[k]; }
}
__device__ __forceinline__ void attn_stream(Frame& F, int b, int g, int h, int res, int dil, int n0, int n1) {
    const bf16* Kh = (const bf16*)(F.ws + WS_KB) + (size_t)(b * 8 + h) * 4096 * 128; const bf16* Vh = (const bf16*)(F.ws + WS_VB) + (size_t)(b * 8 + h) * 4096 * 128;
    const bf16* Qh = (const bf16*)(F.ws + WS_QB) + (size_t)((b * 3 + g) * 8 + h) * 4096 * 128;
    bf16* OG = (bf16*)(F.ws + WS_OG) + (size_t)g * MP * 1024; float* LSE = (float*)(F.ws + WS_LSE) + (size_t)g * MP * 8;
    LAS float* bt = (LAS float*)(F.lds + ATT_BT);
    const int w = F.wave;
    __syncthreads();
    if (F.tid <= 128) bt[F.tid] = ld_in(I_RELB)[t5_bucket(F.tid * dil) * 24 + g * 8 + h] * LOG2E;
    HalfRegs R;
    attn_fetch_half(F, R, Kh, Vh, n0 - 1, res, dil); attn_store_half(F, R, n0 - 1);
    attn_fetch_half(F, R, Kh, Vh, n0, res, dil); attn_store_half(F, R, n0);
    __syncthreads();
    for (int n = n0; n < n1; ++n) {
        int lane = F.lane; asm volatile("" : "+v"(lane));
        const int i = lane & 15, gq = lane >> 4;
        if (n + 1 < n1) attn_fetch_half(F, R, Kh, Vh, n + 1, res, dil);
        const int posq = res + dil * (128 * n + 16 * w + i);
        bf16x8 qf[4];
#pragma unroll
        for (int s = 0; s < 4; ++s) qf[s] = *(const bf16x8*)(Qh + (size_t)posq * 128 + 32 * s + 8 * gq);
        f32x4 sc[9]; float mx = -1e30f;
#pragma unroll
        for (int dk = 0; dk < 9; ++dk) { const int kt = w + dk; f32x4 a = {0.f, 0.f, 0.f, 0.f};
            if (n > 0 || kt >= 8) {
                const LAS unsigned char* kp = F.lds + ATT_K0 + ((n - 1 + (kt >> 3)) & 1) * (128 * KSTR) + ((kt & 7) * 16 + i) * KSTR + 16 * gq;
#pragma unroll
                for (int s = 0; s < 4; ++s) a = mfma16(*(const LAS bf16x8*)(kp + 64 * s), qf[s], a);
#pragma unroll
                for (int r = 0; r < 4; ++r) { const int kk = 4 * gq + r, rel = 128 + i - 16 * dk - kk; float v = a[r] + bt[rel < 0 ? 0 : (rel > 128 ? 128 : rel)];
                    if ((dk == 0 && kk < i) || (dk == 8 && kk > i)) v = -1e30f; a[r] = v; mx = fmaxf(mx, v); }
            } else { a = (f32x4){-1e30f, -1e30f, -1e30f, -1e30f}; }
            sc[dk] = a; }
        mx = fmaxf(mx, __shfl_xor(mx, 16)); mx = fmaxf(mx, __shfl_xor(mx, 32));
        float l = 0.f;
#pragma unroll
        for (int dk = 0; dk < 9; ++dk)
#pragma unroll
            for (int r = 0; r < 4; ++r) { const float p = fexp2(sc[dk][r] - mx); sc[dk][r] = p; l += p; }
        l += __shfl_xor(l, 16); l += __shfl_xor(l, 32);
        const float rl = frcp(l);
        bf16x8 pf[5];
#pragma unroll
        for (int ks = 0; ks < 5; ++ks) { v4u pk; pk.x = cvtpk(sc[2 * ks][0] * rl, sc[2 * ks][1] * rl); pk.y = cvtpk(sc[2 * ks][2] * rl, sc[2 * ks][3] * rl);
            if (ks < 4) { pk.z = cvtpk(sc[2 * ks + 1][0] * rl, sc[2 * ks + 1][1] * rl); pk.w = cvtpk(sc[2 * ks + 1][2] * rl, sc[2 * ks + 1][3] * rl); } else { pk.z = 0u; pk.w = 0u; }
            pf[ks] = __builtin_bit_cast(bf16x8, pk); }
        f32x4 o[8];
#pragma unroll
        for (int dt = 0; dt < 8; ++dt) o[dt] = (f32x4){0.f, 0.f, 0.f, 0.f};
        const int q4 = (lane >> 2) & 3, p4 = lane & 3;
#pragma unroll
        for (int ks = 0; ks < 5; ++ks) { __builtin_amdgcn_sched_barrier(0); const int kt0 = w + 2 * ks, kt1 = (ks < 4) ? kt0 + 1 : kt0;
            const LAS unsigned char* v0 = F.lds + ATT_V0 + ((n - 1 + (kt0 >> 3)) & 1) * (128 * VSTR) + ((kt0 & 7) * 16 + 4 * gq + q4) * VSTR + 8 * p4;
            const LAS unsigned char* v1 = F.lds + ATT_V0 + ((n - 1 + (kt1 >> 3)) & 1) * (128 * VSTR) + ((kt1 & 7) * 16 + 4 * gq + q4) * VSTR + 8 * p4;
#pragma unroll
            for (int dt = 0; dt < 8; ++dt) { const s16x4 lo = tr_read(v0 + 32 * dt), hi = tr_read(v1 + 32 * dt);
                const bf16x8 vf = (bf16x8){lo[0], lo[1], lo[2], lo[3], hi[0], hi[1], hi[2], hi[3]}; o[dt] = mfma16(vf, pf[ks], o[dt]); } }
        const size_t tok = (size_t)b * SEQ + posq; bf16* op = OG + tok * 1024 + h * 128 + 4 * gq;
#pragma unroll
        for (int dt = 0; dt < 8; ++dt) { v2u pk; pk.x = cvtpk(o[dt][0], o[dt][1]); pk.y = cvtpk(o[dt][2], o[dt][3]); *(v2u*)(op + 16 * dt) = pk; }
        if (gq == 0) LSE[tok * 8 + h] = (mx + __builtin_amdgcn_logf(l)) * LN2;
        __syncthreads();
        if (n + 1 < n1) { attn_store_half(F, R, n + 1); __syncthreads(); }
    }
}
__device__ __forceinline__ void p7_attention(Frame& F) {
    for (int u_ = F.vcu; u_ < 768 * REP_B; u_ += F.G) { const int u = u_ % 768; const int g = u >> 8, v = u & 255, b = v >> 6, h = (v >> 3) & 7;
        const int nsub = g == 2 ? 2 : 1;
        for (int sub = 0; sub < nsub; ++sub) { int res, dil, n0, n1;
            if (g == 0) { res = 0; dil = 1; n0 = 4 * (v & 7); n1 = n0 + 4; }
            else if (g == 1) { res = (v >> 1) & 3; dil = 4; n0 = 4 * (v & 1); n1 = n0 + 4; }
            else { res = 2 * (v & 7) + sub; dil = 16; n0 = 0; n1 = 2; }
            attn_stream(F, b, g, h, res, dil, n0, n1); }
    }
}
__device__ __forceinline__ void p8_combine(Frame& F) {
    const bf16* OG = (const bf16*)(F.ws + WS_OG); const float* LSE = (const float*)(F.ws + WS_LSE); const bf16* GS = (const bf16*)(F.ws + WS_GS); bf16* AO = (bf16*)(F.ws + WS_AO);
    const int gt = F.vcu * (NWAVES * 64) + F.tid, NT = F.G * NWAVES * 64;
    for (int e_ = gt; e_ < MP * 128 * REP_E; e_ += NT) { const int e = e_ & (MP * 128 - 1); const int row = e >> 7, c8 = e & 127, h = c8 >> 4;
        const float l0 = LSE[(size_t)row * 8 + h], l1 = LSE[(size_t)(MP + row) * 8 + h], l2 = LSE[(size_t)(2 * MP + row) * 8 + h];
        const float m = fmaxf(l0, fmaxf(l1, l2)); float w0 = fexp(l0 - m), w1 = fexp(l1 - m), w2 = fexp(l2 - m); const float rs = frcp(w0 + w1 + w2); w0 *= rs; w1 *= rs; w2 *= rs;
        float a[8], t[8], gsv[8]; const size_t off = (size_t)row * 1024 + 8 * c8;
        unpack8(*(const v4u*)(OG + off), a);
#pragma unroll
        for (int k = 0; k < 8; ++k) a[k] *= w0;
        unpack8(*(const v4u*)(OG + (size_t)MP * 1024 + off), t);
#pragma unroll
        for (int k = 0; k < 8; ++k) a[k] += w1 * t[k];
        unpack8(*(const v4u*)(OG + (size_t)2 * MP * 1024 + off), t);
        unpack8(*(const v4u*)(GS + off), gsv);
#pragma unroll
        for (int k = 0; k < 8; ++k) a[k] = (a[k] + w2 * t[k]) * gsv[k];
        v4u o; o.x = cvtpk(a[0], a[1]); o.y = cvtpk(a[2], a[3]); o.z = cvtpk(a[4], a[5]); o.w = cvtpk(a[6], a[7]);
        *(v4u*)(AO + off) = o; }
}
__device__ __forceinline__ void p10_final(Frame& F) {
    const float* SSQ2 = (const float*)(F.ws + WS_SSQ2); const float* fn = ld_in(I_FN); float* Y = F.out + O_YP;
    const int gt = F.vcu * (NWAVES * 64) + F.tid, NT = F.G * NWAVES * 64;
    for (int e = gt; e < MP * 256; e += NT) { const int row = e >> 8, c4 = e & 255;
        const f32x4* sp = (const f32x4*)(SSQ2 + (size_t)row * 16); const f32x4 s0 = sp[0], s1 = sp[1], s2 = sp[2], s3 = sp[3];
        const float ss = ((s0[0] + s0[1]) + (s0[2] + s0[3])) + ((s1[0] + s1[1]) + (s1[2] + s1[3])) + ((s2[0] + s2[1]) + (s2[2] + s2[3])) + ((s3[0] + s3[1]) + (s3[2] + s3[3]));
        const float rs = __builtin_amdgcn_rsqf(ss * (1.f / 1024.f) + EPS);
        f32x4* p = (f32x4*)(Y + (size_t)row * 1024) + c4; const f32x4 g4 = ((const f32x4*)fn)[c4]; *p = *p * rs * g4; }
    const float* HS2 = (const float*)(F.ws + WS_HS2);
    for (int m = F.gw; m < MS; m += F.NGW) { const GAS f32x4* xr = (const GAS f32x4*)(HS2 + (size_t)m * DM) + F.lane; const GAS f32x4* gr = (const GAS f32x4*)fn + F.lane;
        f32x4 v[4]; float s = 0.f;
#pragma unroll
        for (int j = 0; j < 4; ++j) { v[j] = xr[64 * j]; s += (v[j].x * v[j].x + v[j].y * v[j].y) + (v[j].z * v[j].z + v[j].w * v[j].w); }
        const float rstd = __builtin_amdgcn_rsqf(wave_sum(s) * (1.f / 1024.f) + EPS);
        f32x4* o = (f32x4*)(F.out + O_YS + (size_t)m * DM) + F.lane;
#pragma unroll
        for (int j = 0; j < 4; ++j) o[64 * j] = v[j] * rstd * gr[64 * j]; }
}
#define RPT(n)
#define PHASES_REST \
      RPT(REP_A) { p2_ssd_a(F); } RPT(REP_D) { p2_sample(F); } GRID_BAR(); \
      RPT(REP_E) { p3_scan(F); } RPT(REP_D) { p3_sample(F); } GRID_BAR(); \
      RPT(REP_A) { p4_ssd_b(F); } RPT(REP_D) { p4_sample(F); } GRID_BAR(); \
      RPT(REP_F) { pg8::Gemm g{(const pg8::bf16_t*)(F.ws + WS_YG), (const pg8::bf16_t*)(F.ws + WS_WOUT), MP, DM, SI}; pg8::StaticOrder S; S.init(MP, DM, F.G, (int)blockIdx.x); S.rep = REP_F; \
               pg8::EpiG2 E{ld_in(I_XP), F.out + O_YP, (pg8::bf16_t*)(F.ws + WS_H1B), (const float*)(F.ws + WS_SSQG), (float*)(F.ws + WS_SSQ1)}; \
               pg8::gemm_phase<pg8::EpiG2, pg8::StaticOrder, true, true>(F.lds, g, S, E); __syncthreads(); } \
             RPT(REP_C) { p5_sample_attn(F); } GRID_BAR(); \
      RPT(REP_F) { pg8::Gemm g{(const pg8::bf16_t*)(F.ws + WS_H1B), (const pg8::bf16_t*)(F.ws + WS_WKVQ), MP, NKVQ, DM}; pg8::StaticOrder S; S.init(MP, NKVQ, F.G, (int)blockIdx.x); S.rep = REP_F; \
               pg8::EpiG3 E{(const float*)(F.ws + WS_SSQ1), (pg8::bf16_t*)(F.ws + WS_KB), (pg8::bf16_t*)(F.ws + WS_VB), (pg8::bf16_t*)(F.ws + WS_QB), (pg8::bf16_t*)(F.ws + WS_GS), F.out + O_KVP}; \
               pg8::gemm_phase<pg8::EpiG3, pg8::StaticOrder, true, true>(F.lds, g, S, E); __syncthreads(); } \
             RPT(REP_D) { p6_sample(F); } GRID_BAR(); \
      RPT(REP_B) { p7_attention(F); } GRID_BAR(); \
      RPT(REP_E) { p8_combine(F); } GRID_BAR(); \
      { pg8::Gemm g{(const pg8::bf16_t*)(F.ws + WS_AO), (const pg8::bf16_t*)(F.ws + WS_WBOUT), MP, DM, DM}; pg8::StaticOrder S; S.init(MP, DM, F.G, (int)blockIdx.x); \
               pg8::EpiG4 E{F.out + O_YP, (float*)(F.ws + WS_SSQ2)}; \
               pg8::gemm_phase<pg8::EpiG4, pg8::StaticOrder, true, true>(F.lds, g, S, E); } \
             GRID_BAR(); \
      p10_final(F);
__global__ void __launch_bounds__(NWAVES * 64, 2) yoco_fwd(Args args) {
    extern __shared__ __attribute__((aligned(16))) unsigned char lds[];
    Frame F;
    F.lds = (LAS unsigned char*)lds; F.MISC = (volatile LAS unsigned*)(F.lds + MISC_OFF);
    F.tid = threadIdx.x; F.lane = F.tid & 63; F.wave = __builtin_amdgcn_readfirstlane(F.tid >> 6);
    F.G = gridDim.x; { const int bx = blockIdx.x; F.vcu = (F.G % 8 == 0) ? (bx % 8) * (F.G / 8) + bx / 8 : bx; }
    F.gw = F.vcu * NWAVES + F.wave; F.NGW = F.G * NWAVES;
    F.out = args.out; F.ws = args.ws; F.ctl = (gu32*)(args.ws + WS_CTL);
    for (int u = F.tid; u < (LDS_BYTES - LDSCTL_OFF) / 4; u += NWAVES * 64) ((LAS unsigned*)(F.lds + LDSCTL_OFF))[u] = 0u;
    __syncthreads();
    XcdBarrier bar = xcd_barrier_post((unsigned*)(F.ctl + CW_BAR), F.MISC + 8);
    if (args.never) cg::this_grid().sync();
#ifndef REP_BAR
#define REP_BAR 1
#endif
#define GRID_BAR() do { xcd_barrier(bar); if (REP_BAR > 1) xcd_barrier(bar); } while (0)

    RPT(REP_E) { p0_prologue(F); __syncthreads(); }
    GRID_BAR();
    {
        pg8::Gemm g{(const pg8::bf16_t*)(F.ws + WS_XN), (const pg8::bf16_t*)(F.ws + WS_WIN), MP, 5120, DM}; pg8::StaticOrder S; S.init(MP, 5120, F.G, (int)blockIdx.x); S.rep = REP_F;
        pg8::EpiG1 E{(pg8::bf16_t*)(F.ws + WS_Z), (pg8::bf16_t*)(F.ws + WS_XBC), F.out + O_CONVP};
        RPT(REP_F) { pg8::gemm_phase<pg8::EpiG1, pg8::StaticOrder, true, true>(F.lds, g, S, E); __syncthreads(); }
        RPT(REP_D) { p1_small(F); }
    }
    GRID_BAR();
    PHASES_REST
}

extern "C" void kernel_launch(void* const* d_in, const int* in_sizes, int n_in, void* d_out, int out_size, void* d_ws, size_t ws_size, hipStream_t stream) {
    static int grid = 0;
    if (grid == 0) {
        if (n_in != N_IN || (size_t)out_size != O_END || ws_size < WS_END) { fprintf(stderr, "kernel_launch: unexpected shapes: n_in %d out %d ws %zu\n", n_in, out_size, ws_size); grid = -1; return; }
        int dev = 0, cus = 0, per_cu = 0;
        if (hipGetDevice(&dev) != hipSuccess || hipDeviceGetAttribute(&cus, hipDeviceAttributeMultiprocessorCount, dev) != hipSuccess) { grid = -1; return; }
        if (hipFuncSetAttribute((const void*)yoco_fwd, hipFuncAttributeMaxDynamicSharedMemorySize, LDS_BYTES) != hipSuccess) { fprintf(stderr, "kernel_launch: hipFuncSetAttribute failed\n"); grid = -1; return; }
        if (hipOccupancyMaxActiveBlocksPerMultiprocessor(&per_cu, (const void*)yoco_fwd, NWAVES * 64, LDS_BYTES) != hipSuccess || per_cu < 1) { fprintf(stderr, "kernel_launch: occupancy query says %d\n", per_cu); (void)hipGetLastError(); grid = -1; return; }
        grid = cus;
    }
    if (grid < 0) return;
    if (hipMemsetAsync((char*)d_ws + WS_CTL, 0, CTL_ZERO_BYTES, stream) != hipSuccess) { fprintf(stderr, "kernel_launch: memset failed\n"); return; }
    Args a{};
    for (int i = 0; i < N_IN; ++i) a.in[i] = (const float*)d_in[i];
    a.out = (float*)d_out; a.ws = (unsigned char*)d_ws; a.never = 0; a.pad = 0;
    void* kargs[] = {&a};
    hipError_t e = hipLaunchCooperativeKernel((const void*)yoco_fwd, dim3(grid), dim3(NWAVES * 64), kargs, LDS_BYTES, stream);
    if (e != hipSuccess) fprintf(stderr, "kernel_launch: cooperative launch failed: %s (grid %d)\n", hipGetErrorString(e), grid);
}
```
